# Optimizing an MI355X kernel written in HIP

```python
import math
import jax, jax.numpy as jnp
from jax import lax
import numpy as np

D_MODEL = 4096
BATCH = 4
SEQ = 4096
DEPTH = 2
DEC_BATCH = 32
DEC_SEQ = 32
PAST_LEN = 2048

CHUNK = 64
N_MIXERS = 2
N_A_LAYERS = (DEPTH + 1) // 2
N_B_LAYERS = DEPTH // 2
A_BLOCK = 128
A_WIDTH = D_MODEL
A_GROUPS = 32
A_GROUP_DIM = A_WIDTH // A_GROUPS
B_EXPAND = 128
B_HEADS = D_MODEL // B_EXPAND
B_DK = B_EXPAND
B_DV = D_MODEL // B_HEADS
B_QK = B_HEADS * B_DK
B_V = B_HEADS * B_DV
B_CHUNK = CHUNK
D_FF = 11008
CONV_W = 3
ALPHA = (2 * DEPTH) ** 0.25
BETA = (8 * DEPTH) ** -0.25
LN_EPS = 1e-5
RMS_EPS = 1e-6

kernel_name = "hybrid_gmlp_hgrn2_convffn_stream_step"


def layer_norm(x, g, b):
    xf = x.astype(jnp.float32)
    mu = jnp.mean(xf, axis=-1, keepdims=True)
    var = jnp.mean(jnp.square(xf - mu), axis=-1, keepdims=True)
    y = (xf - mu) * lax.rsqrt(var + LN_EPS) * g.astype(jnp.float32) + b.astype(jnp.float32)
    return y.astype(x.dtype)


def chunk_mlp_mixer(x, w_in, ln_g, ln_b, w_s, b_s, w_out, blk):
    bn, L, _ = x.shape
    z = jax.nn.gelu(x @ w_in)
    u, v = jnp.split(z, 2, axis=-1)
    v = layer_norm(v, ln_g, ln_b)
    nblk = L // blk
    vb = v.reshape(bn, nblk, blk, A_GROUPS, A_GROUP_DIM)
    causal = jnp.tril(jnp.ones((blk, blk), dtype=bool))
    ws = jnp.where(causal, w_s[:, :blk, :blk], 0.0).astype(v.dtype)
    mixed = jnp.einsum('gts,bnsgc->bntgc', ws, vb) + b_s[:, :blk].T[None, None, :, :, None].astype(v.dtype)
    gated = u * mixed.reshape(bn, L, A_WIDTH)
    return gated @ w_out, v


def gla_chunkwise(q, k, v, logf, S0, chunk):
    bn, L, H, _ = q.shape
    n = L // chunk

    def to_chunks(a):
        return a.reshape(bn, n, chunk, H, a.shape[-1]).transpose(1, 0, 3, 2, 4)

    qc, kc, vc, gc = to_chunks(q), to_chunks(k), to_chunks(v), to_chunks(logf)
    causal = jnp.tril(jnp.ones((chunk, chunk), dtype=bool))[:, :, None]

    def step(S, inp):
        qb, kb, vb, gb = inp
        b = jnp.cumsum(gb, axis=2)
        diff = b[:, :, :, None, :] - b[:, :, None, :, :]
        decay = jnp.exp(jnp.where(causal, diff, -jnp.inf))
        att = jnp.einsum('bhtd,bhtsd,bhsd->bhts', qb, decay, kb)
        o_intra = jnp.einsum('bhts,bhse->bhte', att, vb)
        o_inter = jnp.einsum('bhtd,bhde->bhte', qb * jnp.exp(b), S)
        b_last = b[:, :, -1:, :]
        k_dec = kb * jnp.exp(b_last - b)
        S_new = jnp.exp(b_last[:, :, 0, :])[..., None] * S + jnp.einsum('bhsd,bhse->bhde', k_dec, vb)
        return S_new, o_intra + o_inter

    S_fin, oc = lax.scan(step, S0, (qc, kc, vc, gc))
    o = oc.transpose(1, 0, 3, 2, 4).reshape(bn, L, H, -1)
    return o, S_fin


def hgrn2_mixer(x, S0, lb, w_in, gn_g, w_out, chunk):
    f32 = jnp.float32
    bn, L, _ = x.shape
    h = x @ w_in
    q, zf, i_in, g = jnp.split(h, [B_QK, 2 * B_QK, 2 * B_QK + B_V], axis=-1)
    lbf = lb.astype(f32)
    f = lbf + (1.0 - lbf) * jax.nn.sigmoid(zf.astype(f32))
    logf = jnp.log(f).reshape(bn, L, B_HEADS, B_DK)
    k = (1.0 - f).reshape(bn, L, B_HEADS, B_DK)
    qh = q.astype(f32).reshape(bn, L, B_HEADS, B_DK)
    vh = i_in.astype(f32).reshape(bn, L, B_HEADS, B_DV)
    o, S = gla_chunkwise(qh, k, vh, logf, S0.astype(f32), chunk)
    o = o * lax.rsqrt(jnp.mean(o * o, axis=-1, keepdims=True) + RMS_EPS)
    o = o.reshape(bn, L, B_V) * gn_g.astype(f32) * jax.nn.silu(g.astype(f32))
    return o.astype(x.dtype) @ w_out, S.astype(S0.dtype)


def conv_ffn(x, conv_state, w_up, conv_w, conv_b, w_down):
    L = x.shape[1]
    a, u = jnp.split(x @ w_up, 2, axis=-1)
    ext = jnp.concatenate([conv_state.astype(a.dtype), a], axis=1)
    c = conv_b + ext[:, 0:L] * conv_w[0]
    for j in range(1, CONV_W):
        c = c + ext[:, j:j + L] * conv_w[j]
    y = (jax.nn.silu(c) * u) @ w_down
    return y, ext[:, -(CONV_W - 1):]


def setup_inputs(seed: int = 0) -> dict:
    key = jax.random.key(seed)
    ks = jax.random.split(key, 24)
    f32 = jnp.float32
    D = D_MODEL

    def nrm(k, shape, scale):
        return jax.random.normal(k, shape, f32) * scale

    return {
        "x_prompt": nrm(ks[0], (BATCH, SEQ, D), 1.0),
        "x_sample": nrm(ks[1], (DEC_BATCH, DEC_SEQ, D), 1.0),
        "state_hgrn": nrm(ks[2], (N_B_LAYERS, DEC_BATCH, B_HEADS, B_DK, B_DV), 0.5),
        "cache_conv": nrm(ks[3], (DEPTH, DEC_BATCH, CONV_W - 1, D_FF), 1.0),
        "a_w_in": nrm(ks[4], (N_A_LAYERS, D, 2 * A_WIDTH), D ** -0.5),
        "a_ln_g": 1.0 + nrm(ks[5], (N_A_LAYERS, A_WIDTH), 0.1),
        "a_ln_b": nrm(ks[6], (N_A_LAYERS, A_WIDTH), 0.02),
        "a_w_s": nrm(ks[7], (N_A_LAYERS, A_GROUPS, A_BLOCK, A_BLOCK), A_BLOCK ** -0.5),
        "a_b_s": 1.0 + nrm(ks[8], (N_A_LAYERS, A_GROUPS, A_BLOCK), 0.1),
        "a_w_out": nrm(ks[9], (N_A_LAYERS, A_WIDTH, D), A_WIDTH ** -0.5 * BETA),
        "b_w_in": nrm(ks[10], (N_B_LAYERS, D, 2 * B_QK + B_V + D), D ** -0.5),
        "b_lb": 1.0 + nrm(ks[11], (DEPTH, B_QK), 0.5),
        "b_gn_g": 1.0 + nrm(ks[12], (N_B_LAYERS, B_V), 0.1),
        "b_w_out": nrm(ks[13], (N_B_LAYERS, B_V, D), B_V ** -0.5 * BETA),
        "f_w_up": nrm(ks[14], (DEPTH, D, 2 * D_FF), D ** -0.5),
        "f_conv_w": nrm(ks[15], (DEPTH, CONV_W, D_FF), CONV_W ** -0.5),
        "f_conv_b": nrm(ks[16], (DEPTH, D_FF), 0.01),
        "f_w_down": nrm(ks[17], (DEPTH, D_FF, D), D_FF ** -0.5 * BETA),
        "ln1_g": 1.0 + nrm(ks[18], (DEPTH, D), 0.1),
        "ln1_b": nrm(ks[19], (DEPTH, D), 0.02),
        "ln2_g": 1.0 + nrm(ks[20], (DEPTH, D), 0.1),
        "ln2_b": nrm(ks[21], (DEPTH, D), 0.02),
    }


def reference(x_prompt, x_sample, state_hgrn, cache_conv,
              a_w_in, a_ln_g, a_ln_b, a_w_s, a_b_s, a_w_out,
              b_w_in, b_lb, b_gn_g, b_w_out,
              f_w_up, f_conv_w, f_conv_b, f_w_down,
              ln1_g, ln1_b, ln2_g, ln2_b):
    f32 = jnp.float32
    p = jax.nn.softmax(b_lb.astype(f32), axis=0)
    lower_bounds = jnp.cumsum(p, axis=0) - p[0]

    xp, xs = x_prompt, x_sample
    v_rows, s_prompt, s_sample, c_prompt, c_sample = [], [], [], [], []
    for i in range(DEPTH):
        j = i // N_MIXERS
        if i % N_MIXERS == 0:
            mp, _ = chunk_mlp_mixer(xp, a_w_in[j], a_ln_g[j], a_ln_b[j], a_w_s[j], a_b_s[j], a_w_out[j], A_BLOCK)
            ms, vs = chunk_mlp_mixer(xs, a_w_in[j], a_ln_g[j], a_ln_b[j], a_w_s[j], a_b_s[j], a_w_out[j], xs.shape[1])
            v_rows.append(vs)
        else:
            S0 = jnp.zeros((xp.shape[0], B_HEADS, B_DK, B_DV), state_hgrn.dtype)
            mp, Sp = hgrn2_mixer(xp, S0, lower_bounds[i], b_w_in[j], b_gn_g[j], b_w_out[j], B_CHUNK)
            ms, Ss = hgrn2_mixer(xs, state_hgrn[j], lower_bounds[i], b_w_in[j], b_gn_g[j], b_w_out[j], xs.shape[1])
            s_prompt.append(Sp)
            s_sample.append(Ss)
        xp = layer_norm(ALPHA * xp + mp, ln1_g[i], ln1_b[i])
        xs = layer_norm(ALPHA * xs + ms, ln1_g[i], ln1_b[i])

        c0 = jnp.zeros((xp.shape[0], CONV_W - 1, D_FF), cache_conv.dtype)
        fp, cp = conv_ffn(xp, c0, f_w_up[i], f_conv_w[i], f_conv_b[i], f_w_down[i])
        fs, cs = conv_ffn(xs, cache_conv[i], f_w_up[i], f_conv_w[i], f_conv_b[i], f_w_down[i])
        c_prompt.append(cp)
        c_sample.append(cs)
        xp = layer_norm(ALPHA * xp + fp, ln2_g[i], ln2_b[i])
        xs = layer_norm(ALPHA * xs + fs, ln2_g[i], ln2_b[i])

    return (xp, xs, jnp.stack(v_rows), jnp.stack(s_prompt), jnp.stack(s_sample), jnp.stack(c_prompt), jnp.stack(c_sample))
```

```cpp
#include <hip/hip_runtime.h>
#include <cstdio>
#include <cstdint>
#define LAS __attribute__((address_space(3)))
#define GAS __attribute__((address_space(1)))
#define N_LAUNCHES 1

namespace pg8 {
#define PG8_LAS __attribute__((address_space(3)))
typedef unsigned short bf16_t;
typedef short bf16x8 __attribute__((ext_vector_type(8)));
typedef float f32x4 __attribute__((ext_vector_type(4)));
typedef unsigned u32x4 __attribute__((ext_vector_type(4)));
constexpr int BM = 256, BK = 64, HALF = 128, HTB = HALF * BK * 2  , STAGE_BYTES = 8 * HTB, NXCD = 8, WGM = 8;

__host__ __device__ __forceinline__ int lds_byte(int r, int c) { const int st = (r >> 4) * 2 + (c >> 5), rr = r & 15, cc = c & 31, ob = rr * 64 + cc * 2; return st * 1024 + (ob ^ (((ob >> 9) & 1) << 5)); }
__host__ __device__ __forceinline__ void stage_rc(int b, int& R, int& C) { const int st = b / 1024, sb = b % 1024, swz = sb ^ (((sb >> 9) & 1) << 5); R = (st >> 1) * 16 + swz / 64; C = (st & 1) * 32 + (swz % 64) / 2; }
__host__ __device__ __forceinline__ int perm32(int rho) { const int n = rho >> 4, i = rho & 15; return 8 * (i >> 2) + 4 * n + (i & 3); }

struct Unit { int pm, pn; };
struct Gemm { const bf16_t* A; const bf16_t* Bt; int M, N, K, P; };

struct StaticOrder {
    int nM, nN, nwg, G, c, cap;
    __host__ __device__ void init(int M, int N, int G_, int c_) { nM = M / BM; nN = N / BM; nwg = nM * nN; G = G_; c = c_; cap = nwg; }
    __host__ __device__ bool next(int i, Unit& u) const { return unit_of((long)i * G + c, u); }
    __host__ __device__ bool unit_of(long L, Unit& u) const {
        if (L >= cap) return false;
        int wgid = (int)L;
        { const int nig0 = WGM * nN, rem = nwg - NXCD * nig0;
          if (nM / WGM == NXCD && rem >= 0 && rem % NXCD == 0) {
              const int x = wgid % NXCD, t = wgid / NXCD, rem8 = rem / NXCD;
              wgid = t < nig0 ? x * nig0 + t : NXCD * nig0 + x * rem8 + (t - nig0);
          } else { const int q = nwg / NXCD, r = nwg % NXCD, xcd = wgid % NXCD, off = wgid / NXCD; wgid = (xcd < r ? xcd * (q + 1) : r * (q + 1) + (xcd - r) * q) + off; } }
        const int nig = WGM * nN, gid = wgid / nig, fm = gid * WGM, gsz = (nM - fm) < WGM ? (nM - fm) : WGM;
        u.pm = fm + ((wgid % nig) % gsz); u.pn = (wgid % nig) / gsz; return true;
    }
    __device__ __forceinline__ void a_ready(const Unit&) const {}
    __device__ __forceinline__ void done(const Unit&) const {}
    __device__ __forceinline__ int issue(int, int, int) const { return 0; }
    __device__ __forceinline__ bool resolve(int, int i, Unit& u, int, int) const { return next(i, u); }
};

__device__ __forceinline__ unsigned cvt_pk_bf16(float lo, float hi) { unsigned r; asm volatile("v_cvt_pk_bf16_f32 %0, %1, %2" : "=v"(r) : "v"(lo), "v"(hi)); return r; }
template <class Epi, class Sched, bool ALIGN_EPI = false, bool SP2 = false>
__device__ __forceinline__ void gemm_phase(PG8_LAS unsigned char* lds, const Gemm g, const Sched& S, const Epi& E) {
    int tid_ = threadIdx.x; asm volatile("" : "+v"(tid_));
    const int tid = tid_, wid = __builtin_amdgcn_readfirstlane(tid >> 6), lane = tid & 63, wr = wid >> 2, wc = wid & 3, fr = lane & 15, fq = lane >> 4;
    const int nt = g.K / BK, K = g.P ? g.P : g.K;
    unsigned voffA[2], voffB[2];
#pragma unroll
    for (int i = 0; i < 2; ++i) { int R, C; stage_rc(tid * 16 + i * 8192, R, C); const int Rb = Epi::PERM ? ((R & ~31) + perm32(R & 31)) : R;
        voffA[i] = (unsigned)(R * K + C) * 2u; voffB[i] = (unsigned)(Rb * K + C) * 2u; }
    const size_t kstep = (size_t)(BK * 2);
    const size_t hstep = (size_t)HALF * K * 2;
    const size_t tstep = 2 * hstep;
    const unsigned ldsw = (unsigned)wid * 1024u;
    const int aoff = lds_byte(wr * 64 + fr, fq * 8), boff = lds_byte(wc * 32 + fr, fq * 8);
#define PG8_SA(b, h) (((b) * 2 + (h)) * HTB)
#define PG8_SB(b, h) ((4 + (b) * 2 + (h)) * HTB)
#define PG8_STAGE(bufoff, gbase, voff) do { _Pragma("unroll") for (int _i = 0; _i < 2; ++_i) \
        __builtin_amdgcn_global_load_lds((const unsigned*)((const char*)(gbase) + (voff)[_i]), (PG8_LAS unsigned*)(lds + (bufoff) + ldsw + _i * 8192), 16, 0, 0); } while (0)
#define PG8_LDA(dst, b, h) do { _Pragma("unroll") for (int m = 0; m < 4; ++m) _Pragma("unroll") for (int k = 0; k < 2; ++k) dst[m][k] = *(const PG8_LAS bf16x8*)(lds + PG8_SA(b, h) + aoff + m * 2048 + k * 1024); } while (0)
#define PG8_LDB(dst, b, h) do { _Pragma("unroll") for (int n = 0; n < 2; ++n) _Pragma("unroll") for (int k = 0; k < 2; ++k) dst[n][k] = *(const PG8_LAS bf16x8*)(lds + PG8_SB(b, h) + boff + n * 2048 + k * 1024); } while (0)
#define PG8_MMA(ai, bj, At, Bt) do { __builtin_amdgcn_s_setprio(1); _Pragma("unroll") for (int m = 0; m < 4; ++m) _Pragma("unroll") for (int n = 0; n < 2; ++n) _Pragma("unroll") for (int k = 0; k < 2; ++k) \
        acc[ai][bj][m][n] = __builtin_amdgcn_mfma_f32_16x16x32_bf16(Bt[n][k], At[m][k], acc[ai][bj][m][n], 0, 0, 0); __builtin_amdgcn_s_setprio(0); } while (0)
#define PG8_WAIT_V(n) asm volatile("s_waitcnt vmcnt(" #n ")" ::: "memory")
#define PG8_WAIT_L(n) asm volatile("s_waitcnt lgkmcnt(" #n ")" ::: "memory")
#define PG8_BAR __builtin_amdgcn_s_barrier()
#define PG8_SCHED __builtin_amdgcn_sched_barrier(0)
    Unit cur, nxt; int ui = 0;
    { const int tk0 = S.issue(0, wid, lane); if (!S.resolve(tk0, 0, cur, wid, lane)) return; }
    f32x4 acc[2][2][4][2];
#pragma unroll
    for (int a = 0; a < 2; ++a)
#pragma unroll
        for (int b = 0; b < 2; ++b)
#pragma unroll
            for (int m = 0; m < 4; ++m)
#pragma unroll
                for (int n = 0; n < 2; ++n) acc[a][b][m][n] = (f32x4){0.f, 0.f, 0.f, 0.f};
    bf16x8 At[4][2], B0[2][2], B1[2][2];
    const char* cA = (const char*)g.A + (size_t)cur.pm * tstep; const char* cB = (const char*)g.Bt + (size_t)cur.pn * tstep;
    S.a_ready(cur);
    if constexpr (SP2) {
        PG8_STAGE(PG8_SB(0, 0), cB, voffB); PG8_STAGE(PG8_SB(0, 1), cB + hstep, voffB); PG8_STAGE(PG8_SA(0, 0), cA, voffA); PG8_STAGE(PG8_SA(0, 1), cA + hstep, voffA);
        if (wr == 1) PG8_BAR;
        PG8_WAIT_V(2); PG8_BAR;
        PG8_STAGE(PG8_SB(1, 0), cB + kstep, voffB); PG8_STAGE(PG8_SA(1, 0), cA + kstep, voffA); PG8_STAGE(PG8_SB(1, 1), cB + hstep + kstep, voffB);
        PG8_WAIT_V(6); PG8_BAR;
    } else {
        PG8_STAGE(PG8_SB(0, 0), cB, voffB); PG8_STAGE(PG8_SA(0, 0), cA, voffA); PG8_STAGE(PG8_SB(0, 1), cB + hstep, voffB); PG8_STAGE(PG8_SA(0, 1), cA + hstep, voffA);
        if (wr == 1) PG8_BAR;
        PG8_WAIT_V(4); PG8_BAR;
        PG8_STAGE(PG8_SB(1, 0), cB + kstep, voffB); PG8_STAGE(PG8_SA(1, 0), cA + kstep, voffA); PG8_STAGE(PG8_SB(1, 1), cB + hstep + kstep, voffB);
        PG8_WAIT_V(6); PG8_BAR;
    }
    for (;;) {
        const int tk = S.issue(ui + 1, wid, lane);
        bool has_next = false;
        const char* nA = cA; const char* nB = cB;
        for (int t = 0; t < nt; t += 2) {
            const bool last = (t == nt - 2);
            if (last) { has_next = S.resolve(tk, ui + 1, nxt, wid, lane); if (has_next) { nA = (const char*)g.A + (size_t)nxt.pm * tstep; nB = (const char*)g.Bt + (size_t)nxt.pn * tstep; } }
            const char* a1 = cA + (size_t)(t + 1) * kstep;
            const char* a2 = last ? nA : cA + (size_t)(t + 2) * kstep; const char* b2 = last ? nB : cB + (size_t)(t + 2) * kstep;
            const char* a3 = a2 + kstep; const char* b3 = b2 + kstep;
            if (last && has_next) S.a_ready(nxt);
            if constexpr (SP2) {
            PG8_LDB(B0, 0, 0); PG8_LDB(B1, 0, 1); PG8_SCHED; PG8_LDA(At, 0, 0); PG8_STAGE(PG8_SA(1, 1), a1 + hstep, voffA);
            PG8_WAIT_V(8); PG8_WAIT_L(0); PG8_BAR; PG8_MMA(0, 0, At, B0); PG8_MMA(0, 1, At, B1); PG8_BAR; PG8_SCHED;
            PG8_LDA(At, 0, 1); PG8_STAGE(PG8_SB(0, 0), b2, voffB); PG8_STAGE(PG8_SB(0, 1), b2 + hstep, voffB); PG8_STAGE(PG8_SA(0, 0), a2, voffA);
            PG8_WAIT_V(8); PG8_WAIT_L(0); PG8_BAR; PG8_MMA(1, 0, At, B0); PG8_MMA(1, 1, At, B1); PG8_BAR; PG8_SCHED;
            PG8_LDB(B0, 1, 0); PG8_LDB(B1, 1, 1); PG8_SCHED; PG8_LDA(At, 1, 0); PG8_STAGE(PG8_SA(0, 1), a2 + hstep, voffA);
            PG8_WAIT_V(8); PG8_WAIT_L(0); PG8_BAR; PG8_MMA(0, 0, At, B0); PG8_MMA(0, 1, At, B1); PG8_BAR; PG8_SCHED;
            PG8_LDA(At, 1, 1); PG8_STAGE(PG8_SB(1, 0), b3, voffB); PG8_STAGE(PG8_SB(1, 1), b3 + hstep, voffB); PG8_STAGE(PG8_SA(1, 0), a3, voffA);
            PG8_WAIT_V(8); PG8_WAIT_L(0); PG8_BAR; PG8_MMA(1, 0, At, B0); PG8_MMA(1, 1, At, B1); PG8_BAR; PG8_SCHED;
            } else {
            PG8_LDB(B0, 0, 0); PG8_SCHED; PG8_LDA(At, 0, 0); PG8_STAGE(PG8_SA(1, 1), a1 + hstep, voffA);
            PG8_WAIT_L(8); PG8_BAR; PG8_WAIT_L(0); PG8_MMA(0, 0, At, B0); PG8_BAR; PG8_SCHED;
            PG8_LDB(B1, 0, 1); PG8_STAGE(PG8_SB(0, 0), b2, voffB);
            PG8_BAR; PG8_WAIT_L(0); PG8_MMA(0, 1, At, B1); PG8_BAR;
            PG8_LDA(At, 0, 1); PG8_STAGE(PG8_SA(0, 0), a2, voffA);
            PG8_BAR; PG8_WAIT_L(0); PG8_MMA(1, 0, At, B0); PG8_BAR; PG8_SCHED;
            PG8_STAGE(PG8_SB(0, 1), b2 + hstep, voffB);
            PG8_WAIT_V(6); PG8_BAR; PG8_MMA(1, 1, At, B1); PG8_BAR;
            PG8_LDB(B0, 1, 0); PG8_SCHED; PG8_LDA(At, 1, 0); PG8_STAGE(PG8_SA(0, 1), a2 + hstep, voffA);
            PG8_WAIT_L(8); PG8_BAR; PG8_WAIT_L(0); PG8_MMA(0, 0, At, B0); PG8_BAR; PG8_SCHED;
            PG8_LDB(B1, 1, 1); PG8_STAGE(PG8_SB(1, 0), b3, voffB);
            PG8_BAR; PG8_WAIT_L(0); PG8_MMA(0, 1, At, B1); PG8_BAR;
            PG8_LDA(At, 1, 1); PG8_STAGE(PG8_SA(1, 0), a3, voffA);
            PG8_BAR; PG8_WAIT_L(0); PG8_MMA(1, 0, At, B0); PG8_BAR; PG8_SCHED;
            PG8_STAGE(PG8_SB(1, 1), b3 + hstep, voffB);
            PG8_WAIT_V(6); PG8_BAR; PG8_MMA(1, 1, At, B1); PG8_BAR;
            }
        }
        if constexpr (ALIGN_EPI) { if (wr == 0) PG8_BAR; }
        if constexpr (!Epi::AFTER_DRAIN) { E(acc, cur, wr, wc, fr, fq); S.done(cur); }
        if (!has_next) break;
#pragma unroll
        for (int a = 0; a < 2; ++a)
#pragma unroll
            for (int b = 0; b < 2; ++b)
#pragma unroll
                for (int m = 0; m < 4; ++m)
#pragma unroll
                    for (int n = 0; n < 2; ++n) acc[a][b][m][n] = (f32x4){0.f, 0.f, 0.f, 0.f};
        cur = nxt; cA = nA; cB = nB; ++ui;
        if constexpr (ALIGN_EPI) { if (wr == 1) PG8_BAR; }
    }
    PG8_WAIT_V(0);
    if constexpr (!ALIGN_EPI) { if (wr == 0) PG8_BAR; }
    PG8_BAR;
    if constexpr (Epi::AFTER_DRAIN) { E.fused(acc, cur, wr, wc, fr, fq, lds, wid, lane); S.done(cur); }
#undef PG8_SA
#undef PG8_SB
#undef PG8_STAGE
#undef PG8_LDA
#undef PG8_LDB
#undef PG8_MMA
#undef PG8_WAIT_V
#undef PG8_WAIT_L
#undef PG8_BAR
#undef PG8_SCHED
}
}
#define XB_TMO      128
#define XB_XCNT(j)  (256  + 64 * (j))
#define XB_XSUB(j)  (1280 + 64 * (j))
#define XB_XGEN(j)  (2304 + 64 * (j))
#define XB_TOP      3328
#define XB_TOPGEN   3392
#define XCD_BAR_WORDS 3456
#define XB_SPIN_CAP (1u << 18)

__device__ __forceinline__ unsigned xb_ld(unsigned* p)              { return __hip_atomic_load(p, __ATOMIC_RELAXED, __HIP_MEMORY_SCOPE_AGENT); }
__device__ __forceinline__ unsigned xb_add(unsigned* p, unsigned v) { return __hip_atomic_fetch_add(p, v, __ATOMIC_RELAXED, __HIP_MEMORY_SCOPE_AGENT); }
__device__ __forceinline__ unsigned xb_xcc_id() { return (unsigned)__builtin_amdgcn_s_getreg((3 << 11) | 20) & 0xFu; }
#define XB_SPIN(cond, bar) do { unsigned _sp = 0; while (cond) { __builtin_amdgcn_s_sleep(1); \
    if ((++_sp & 255u) == 0u) { if (xb_ld(&(bar)[XB_TMO])) break; if (_sp > XB_SPIN_CAP) { atomicAdd(&(bar)[XB_TMO], 1u); break; } } } } while (0)

struct XcdBarrier {
    unsigned* bar; unsigned x;
    volatile LAS unsigned* st;
};

__device__ __forceinline__ XcdBarrier xcd_barrier_post(unsigned* bar, volatile LAS unsigned* st) {
    XcdBarrier b; b.bar = bar; b.x = xb_xcc_id(); b.st = st;
    if (threadIdx.x == 0) (void)xb_add(&bar[XB_XCNT(b.x)], 1u);
    return b;
}
__device__ __forceinline__ void xcd_barrier_complete(unsigned* bar, unsigned x, unsigned& nloc, unsigned& nx) {
    const unsigned G = gridDim.x * gridDim.y * gridDim.z;
    unsigned sum, cnt, mine, sp = 0u;
    for (;;) {
        sum = 0u; cnt = 0u; mine = 0u;
#pragma unroll
        for (unsigned j = 0; j < 16; ++j) { const unsigned c = xb_ld(&bar[XB_XCNT(j)]); sum += c; cnt += (c > 0u) ? 1u : 0u; mine = (j == x) ? c : mine; }
        if (sum == G) break;
        __builtin_amdgcn_s_sleep(1);
        if ((++sp & 255u) == 0u) { if (xb_ld(&bar[XB_TMO])) break; if (sp > XB_SPIN_CAP) { atomicAdd(&bar[XB_TMO], 1u); break; } }
    }
    nloc = mine > 0u ? mine : 1u; nx = cnt > 0u ? cnt : 1u;
}

__device__ __forceinline__ void xcd_barrier(const XcdBarrier& b) {
    asm volatile("s_waitcnt vmcnt(0)" ::: "memory");
    __syncthreads();
    if (threadIdx.x == 0) {
        unsigned* bar = b.bar;
        __builtin_amdgcn_s_waitcnt(0);
        unsigned nloc = b.st[0], nx = b.st[1];
        if (nloc == 0u) { xcd_barrier_complete(bar, b.x, nloc, nx); b.st[0] = nloc; b.st[1] = nx; }
        const unsigned old = xb_add(&bar[XB_XSUB(b.x)], 1u);
        const unsigned gen = old / nloc;
        if (old + 1u == (gen + 1u) * nloc) {
            __builtin_amdgcn_fence(__ATOMIC_RELEASE, "agent");
            asm volatile("s_waitcnt vmcnt(0)" ::: "memory");
            const unsigned og = xb_add(&bar[XB_TOP], 1u);
            const unsigned tg = og / nx;
            if (og + 1u == (tg + 1u) * nx) xb_add(&bar[XB_TOPGEN], 1u);
            else XB_SPIN(xb_ld(&bar[XB_TOPGEN]) == tg, bar);
            __builtin_amdgcn_fence(__ATOMIC_ACQUIRE, "agent");
            xb_add(&bar[XB_XGEN(b.x)], 1u);
            asm volatile("s_waitcnt vmcnt(0)" ::: "memory");
        } else {
            XB_SPIN(xb_ld(&bar[XB_XGEN(b.x)]) == gen, bar);
            __builtin_amdgcn_fence(__ATOMIC_ACQUIRE, "agent");
            asm volatile("s_waitcnt vmcnt(0)" ::: "memory");
        }
    }
    __syncthreads();
}
#ifndef N_LAUNCHES
#define N_LAUNCHES 1
#endif
constexpr int MP = 16384, MS = 1024, M = MP + MS, D = 4096, DFF = 11008, NUP = 2 * DFF, NAIN = 8192, NBIN = 16384;
constexpr int NPHASE = 20;
constexpr float ALPHA = 1.41421356237309515f, LN_EPS = 1e-5f, RMS_EPS = 1e-6f;
typedef unsigned short bf16_t;
typedef float f32x4 __attribute__((ext_vector_type(4)));
typedef float f32x2 __attribute__((ext_vector_type(2)));
typedef unsigned u32x4 __attribute__((ext_vector_type(4)));
typedef unsigned u32x2 __attribute__((ext_vector_type(2)));
typedef short bf16x8 __attribute__((ext_vector_type(8)));
typedef short s16x4 __attribute__((ext_vector_type(4)));

constexpr size_t MiB = 1u << 20;
constexpr size_t WS_CTL = 0, CTL_BYTES = 1 * MiB;
constexpr size_t WS_W_AIN = 1 * MiB;
constexpr size_t WS_W_AOUT = WS_W_AIN + 64 * MiB;
constexpr size_t WS_W_UP0 = WS_W_AOUT + 32 * MiB;
constexpr size_t WS_W_DN0 = WS_W_UP0 + 172 * MiB;
constexpr size_t WS_W_BIN = WS_W_DN0 + 86 * MiB;
constexpr size_t WS_W_BOUT = WS_W_BIN + 128 * MiB;
constexpr size_t WS_W_UP1 = WS_W_BOUT + 32 * MiB;
constexpr size_t WS_W_DN1 = WS_W_UP1 + 172 * MiB;
constexpr size_t WS_XB = WS_W_DN1 + 86 * MiB;
constexpr size_t WS_X32 = WS_XB + 136 * MiB;
constexpr size_t WS_H32 = WS_X32 + 272 * MiB;
constexpr size_t WS_STAT = WS_H32 + 272 * MiB;
constexpr size_t WS_ROWSTAT = WS_STAT + 9 * MiB;
constexpr size_t WS_LB = WS_ROWSTAT + 512 * 1024;
constexpr size_t WS_RS2 = WS_ROWSTAT + 768 * 1024;
constexpr size_t WS_BIG = WS_ROWSTAT + 1 * MiB;
constexpr size_t WS_Z = WS_BIG;
constexpr size_t WS_GATED = WS_BIG + 272 * MiB;
constexpr size_t WS_SIDE = WS_BIG;
constexpr size_t WS_HG = WS_BIG + 731 * MiB;
constexpr size_t WS_Q = WS_BIG;
constexpr size_t WS_ZF = WS_BIG + 136 * MiB;
constexpr size_t WS_V = WS_BIG + 272 * MiB;
constexpr size_t WS_G = WS_BIG + 408 * MiB;
constexpr size_t WS_O = WS_BIG + 816 * MiB;
constexpr size_t WS_DCH = WS_BIG + 952 * MiB;
constexpr size_t WS_QS = WS_X32;
constexpr size_t WS_KD = WS_X32 + 136 * MiB;
constexpr size_t WS_SLAB = WS_BIG + 128 * MiB;
constexpr size_t WS_END = WS_BIG + 1097 * MiB;
static_assert(WS_HG + (size_t)M * DFF * 2 <= WS_END && WS_DCH + (size_t)(M / 32) * D * 4 <= WS_END, "ws map");
constexpr size_t OUT_Y = 0, OUT_NV = (size_t)M * D, OUT_SP = OUT_NV + (size_t)MS * D, OUT_SS = OUT_SP + (size_t)4 * 32 * 128 * 128,
                 OUT_CP = OUT_SS + (size_t)32 * 32 * 128 * 128, OUT_CS = OUT_CP + (size_t)2 * 4 * 2 * DFF, OUT_END = OUT_CS + (size_t)2 * 32 * 2 * DFF;
constexpr int LDS_BYTES = 163840, MISC_OFF = LDS_BYTES - 256, PTR_OFF = LDS_BYTES - 512;
constexpr int CW_BAR = 4096;

__device__ __forceinline__ float bf2f(unsigned b16) { return __uint_as_float(b16 << 16); }
typedef __bf16 bf16x2_t __attribute__((ext_vector_type(2)));
__device__ __forceinline__ unsigned pk2(float lo, float hi) { const f32x2 v = {lo, hi}; const bf16x2_t b = __builtin_convertvector(v, bf16x2_t); return __builtin_bit_cast(unsigned, b); }
__device__ __forceinline__ float bflo(unsigned w) { return __uint_as_float(w << 16); }
__device__ __forceinline__ float bfhi(unsigned w) { return __uint_as_float(w & 0xffff0000u); }
__device__ __forceinline__ float wave_sum(float v) {
#pragma unroll
    for (int o = 1; o < 64; o <<= 1) v += __shfl_xor(v, o);
    return v;
}
__device__ __forceinline__ float fexp(float x) { return __builtin_amdgcn_exp2f(x * 1.44269504088896341f); }
__device__ __forceinline__ float frcp(float x) { return __builtin_amdgcn_rcpf(x); }
__device__ __forceinline__ float fsigmoid(float x) { return frcp(1.0f + fexp(-x)); }
__device__ __forceinline__ float fsilu(float x) { return x * fsigmoid(x); }
__device__ __forceinline__ float fgelu_tanh(float x) {
    const float t = x * (1.5957691216057308f + 0.07135481627f * x * x);
    return x * frcp(1.0f + fexp(-t));
}
__device__ __forceinline__ s16x4 lds_tr(LAS unsigned char* p) { return __builtin_amdgcn_ds_read_tr16_b64_v4i16((LAS s16x4*)p); }
__device__ __forceinline__ bf16x8 cat4(s16x4 a, s16x4 b) { return (bf16x8){a[0], a[1], a[2], a[3], b[0], b[1], b[2], b[3]}; }
template <class T> __device__ __forceinline__ T ldo(const void* ubase, unsigned boff) { return *(const T*)((const char*)ubase + boff); }
template <class T> __device__ __forceinline__ void sto(void* ubase, unsigned boff, T v) { *(T*)((char*)ubase + boff) = v; }
#define LDS_WAIT() asm volatile("s_waitcnt lgkmcnt(0)" ::: "memory")
#define VM_WAIT() asm volatile("s_waitcnt vmcnt(0)" ::: "memory")

struct Ctx {
    LAS unsigned char* lds;
    int tid, lane, wave, G, bid;
};
extern __shared__ __attribute__((aligned(16))) unsigned char lds_raw[];
__device__ __forceinline__ Ctx make_ctx() {
    Ctx C; C.lds = (LAS unsigned char*)lds_raw; int t = threadIdx.x; asm volatile("" : "+v"(t));
    C.tid = t; C.lane = t & 63; C.wave = __builtin_amdgcn_readfirstlane(t >> 6); C.G = gridDim.x; C.bid = blockIdx.x; return C;
}
__device__ __forceinline__ unsigned long long ptab(const Ctx& C, int k) {
    const unsigned lo = *(volatile LAS unsigned*)(C.lds + PTR_OFF + 8 * k), hi = *(volatile LAS unsigned*)(C.lds + PTR_OFF + 8 * k + 4);
    return ((unsigned long long)(unsigned)__builtin_amdgcn_readfirstlane((int)hi) << 32) | (unsigned)__builtin_amdgcn_readfirstlane((int)lo);
}
__device__ __forceinline__ const float* inp(const Ctx& C, int k) { return (const float*)(GAS const float*)ptab(C, k); }
__device__ __forceinline__ float* outp(const Ctx& C) { return (float*)(GAS float*)ptab(C, 22); }
__device__ __forceinline__ unsigned char* wsp(const Ctx& C) { return (unsigned char*)(GAS unsigned char*)ptab(C, 23); }
__device__ __forceinline__ const float* xin_row(const float* xp, const float* xs, int row) { return row < MP ? xp + (size_t)row * D : xs + (size_t)(row - MP) * D; }

struct EpiGelu {
    static constexpr bool PERM = true, AFTER_DRAIN = false;
    bf16_t* Z; float* stat;
    __device__ __forceinline__ void operator()(const pg8::f32x4 (&acc)[2][2][4][2], const pg8::Unit& u, int wr, int wc, int fr, int fq) const {
        const int row0 = u.pm * 256 + wr * 64 + fr, col0 = u.pn * 256 + wc * 32 + 8 * fq;
        const bool isv = u.pn >= 16;
#pragma unroll
        for (int ai = 0; ai < 2; ++ai)
#pragma unroll
            for (int m = 0; m < 4; ++m) {
                const int row = row0 + ai * 128 + m * 16; float s1 = 0.f, s2 = 0.f;
#pragma unroll
                for (int bj = 0; bj < 2; ++bj) {
                    float z[8];
#pragma unroll
                    for (int j = 0; j < 4; ++j) { z[j] = fgelu_tanh(acc[ai][bj][m][0][j]); z[4 + j] = fgelu_tanh(acc[ai][bj][m][1][j]); }
#pragma unroll
                    for (int j = 0; j < 8; ++j) { s1 += z[j]; s2 += z[j] * z[j]; }
                    u32x4 w; w.x = pk2(z[0], z[1]); w.y = pk2(z[2], z[3]); w.z = pk2(z[4], z[5]); w.w = pk2(z[6], z[7]);
                    *(u32x4*)(Z + (size_t)row * NAIN + col0 + bj * 128) = w;
                }
                if (isv) {
                    s1 += __shfl_xor(s1, 16); s1 += __shfl_xor(s1, 32); s2 += __shfl_xor(s2, 16); s2 += __shfl_xor(s2, 32);
                    if (fq == 0) *(f32x2*)(stat + ((size_t)row * 64 + (u.pn - 16) * 4 + wc) * 2) = (f32x2){s1, s2};
                }
            }
    }
};
template <int MODE> struct EpiRes {
    static constexpr bool PERM = true, AFTER_DRAIN = false;
    const float* xa; const float* xb; const f32x2* rs; const float* lng; const float* lnb;
    bf16_t* H; float* stat;
    __device__ __forceinline__ void operator()(const pg8::f32x4 (&acc)[2][2][4][2], const pg8::Unit& u, int wr, int wc, int fr, int fq) const { run<0, 2>(acc, u, wr, wc, fr, fq); }
    template <int AI0, int AI1, int M0 = 0, int M1 = 4> __device__ __forceinline__ void run(const pg8::f32x4 (&acc)[2][2][4][2], const pg8::Unit& u, int wr, int wc, int fr, int fq) const {
        const int row0 = u.pm * 256 + wr * 64 + fr, col0 = u.pn * 256 + wc * 32 + 8 * fq;
        const float* xbase = nullptr;
        if (MODE == 0) xbase = (u.pm < MP / 256) ? xa + (size_t)row0 * D : xb + (size_t)(row0 - MP) * D;
        float s1[8], s2[8];
#pragma unroll
        for (int i = 0; i < 8; ++i) { s1[i] = 0.f; s2[i] = 0.f; }
#pragma unroll
        for (int bj = 0; bj < 2; ++bj) {
            f32x4 g0, g1, b0, b1;
            if (MODE == 1) { const float* gp = lng + col0 + bj * 128; const float* bp = lnb + col0 + bj * 128; g0 = *(const f32x4*)gp; g1 = *(const f32x4*)(gp + 4); b0 = *(const f32x4*)bp; b1 = *(const f32x4*)(bp + 4); }
#pragma unroll
            for (int ai = AI0; ai < AI1; ++ai)
#pragma unroll
                for (int m = M0; m < M1; ++m) {
                    const int ro = ai * 128 + m * 16;
                    bf16_t* hp = H + (size_t)(row0 + ro) * D + col0 + bj * 128;
                    f32x4 x0, x1;
                    if (MODE == 0) { const float* xp = xbase + (size_t)ro * D + col0 + bj * 128; x0 = *(const f32x4*)xp; x1 = *(const f32x4*)(xp + 4); }
                    else { const f32x2 st = rs[row0 + ro]; const u32x4 hw = *(const u32x4*)hp;
                        x0 = ((f32x4){bflo(hw.x), bfhi(hw.x), bflo(hw.y), bfhi(hw.y)} - st[0]) * st[1] * g0 + b0; x1 = ((f32x4){bflo(hw.z), bfhi(hw.z), bflo(hw.w), bfhi(hw.w)} - st[0]) * st[1] * g1 + b1; }
                    const f32x4 h0 = x0 * ALPHA + acc[ai][bj][m][0], h1 = x1 * ALPHA + acc[ai][bj][m][1];
                    *(u32x4*)hp = (u32x4){pk2(h0[0], h0[1]), pk2(h0[2], h0[3]), pk2(h1[0], h1[1]), pk2(h1[2], h1[3])};
#pragma unroll
                    for (int j = 0; j < 4; ++j) { s1[ai * 4 + m] += h0[j] + h1[j]; s2[ai * 4 + m] += h0[j] * h0[j] + h1[j] * h1[j]; }
                    asm volatile("" ::: "memory");
                }
        }
#pragma unroll
        for (int i = AI0 * 4; i < AI1 * 4; ++i) {
            if ((i & 3) < M0 || (i & 3) >= M1) continue;
            float a = s1[i], q = s2[i];
            a += __shfl_xor(a, 16); a += __shfl_xor(a, 32); q += __shfl_xor(q, 16); q += __shfl_xor(q, 32);
            if (fq == 0) *(f32x2*)(stat + ((size_t)(row0 + (i >> 2) * 128 + (i & 3) * 16) * 64 + u.pn * 4 + wc) * 2) = (f32x2){a, q};
        }
    }
};
struct EpiNull {
    static constexpr bool PERM = true, AFTER_DRAIN = false;
    float* sink;
    __device__ __forceinline__ void operator()(const pg8::f32x4 (&acc)[2][2][4][2], const pg8::Unit& u, int wr, int wc, int fr, int fq) const {
        float s = 0.f;
#pragma unroll
        for (int ai = 0; ai < 2; ++ai)
#pragma unroll
            for (int bj = 0; bj < 2; ++bj)
#pragma unroll
                for (int m = 0; m < 4; ++m)
#pragma unroll
                    for (int n = 0; n < 2; ++n) s += acc[ai][bj][m][n][0] + acc[ai][bj][m][n][1] + acc[ai][bj][m][n][2] + acc[ai][bj][m][n][3];
        if (s == 12345.678f) sink[u.pm * 64 + fr] = s;
    }
};
constexpr int CW_Q = 8192, CW_CV = 16384;
struct QueueOrder {
    pg8::StaticOrder b; unsigned* q; int x; volatile LAS int* slot;
    __device__ __forceinline__ int issue(int, int wid, int lane) const {
        int L = -1;
        if (wid == 0 && lane == 0) {
            for (int y = 0; y < 8; ++y) {
                const int x2 = (x + y) & 7; const unsigned t = __hip_atomic_fetch_add(q + 64 * x2, 1u, __ATOMIC_RELAXED, __HIP_MEMORY_SCOPE_AGENT);
                const long Lc = (long)t * 8 + x2; if (Lc < b.cap) { L = (int)Lc; break; }
            }
        }
        return L;
    }
    __device__ __forceinline__ bool resolve(int L, int i, pg8::Unit& u, int wid, int lane) const {
        if (wid == 0 && lane == 0) slot[i & 1] = L;
        asm volatile("s_waitcnt lgkmcnt(0)" ::: "memory"); __builtin_amdgcn_s_barrier(); asm volatile("" ::: "memory");
        const int Lr = __builtin_amdgcn_readfirstlane(slot[i & 1]);
        return Lr >= 0 && b.unit_of(Lr, u);
    }
    __device__ __forceinline__ void a_ready(const pg8::Unit&) const {}
    __device__ __forceinline__ void done(const pg8::Unit&) const {}
};
__device__ __forceinline__ QueueOrder make_queue(const Ctx& C, unsigned char* ws_, int pid, int Mr, int Nc) {
    QueueOrder S; S.b.init(Mr, Nc, C.G, 0); S.q = (unsigned*)(ws_ + WS_CTL) + CW_Q + pid * 8 * 64; S.x = C.bid & 7; S.slot = (volatile LAS int*)(C.lds + MISC_OFF) + 16; return S;
}
struct SplitOrder {
    pg8::StaticOrder b; long L;
    __device__ bool next(int i, pg8::Unit& u) const { return i == 0 && b.unit_of(L, u); }
    __device__ __forceinline__ int issue(int, int, int) const { return 0; }
    __device__ __forceinline__ bool resolve(int, int i, pg8::Unit& u, int, int) const { return next(i, u); }
    __device__ __forceinline__ void a_ready(const pg8::Unit&) const {}
    __device__ __forceinline__ void done(const pg8::Unit&) const {}
};
struct EpiPartial {
    static constexpr bool PERM = true, AFTER_DRAIN = false;
    float* slab;
    __device__ __forceinline__ void operator()(const pg8::f32x4 (&acc)[2][2][4][2], const pg8::Unit&, int wr, int wc, int fr, int fq) const {
        const unsigned t = (unsigned)(((wr * 4 + wc) * 4 + fq) * 16 + fr);
#pragma unroll
        for (int ai = 0; ai < 2; ++ai)
#pragma unroll
            for (int bj = 0; bj < 2; ++bj)
#pragma unroll
                for (int m = 0; m < 4; ++m)
#pragma unroll
                    for (int n = 0; n < 2; ++n) sto<pg8::f32x4>(slab, ((unsigned)((((ai * 2 + bj) * 4 + m) * 2 + n) * 512) + t) * 16u, acc[ai][bj][m][n]);
    }
};
struct EpiUpConv {
    static constexpr bool PERM = true, AFTER_DRAIN = false;
    bf16_t* HG; bf16_t* SIDE; float* cp; float* cs; const float* cw; const float* cb;
    __device__ __forceinline__ void operator()(const pg8::f32x4 (&acc)[2][2][4][2], const pg8::Unit& u, int wr, int wc, int fr, int fq) const {
        const int row0 = u.pm * 256 + wr * 64 + fr, ch0 = u.pn * 128 + wc * 32 + 8 * fq;
        const int lane = fq * 16 + fr, L1 = (lane & 48) | ((fr - 1) & 15), L2 = (lane & 48) | ((fr - 2) & 15);
        f32x4 w0[2], w1[2], w2[2], bb[2];
#pragma unroll
        for (int n = 0; n < 2; ++n) { w0[n] = *(const f32x4*)(cw + ch0 + 4 * n); w1[n] = *(const f32x4*)(cw + DFF + ch0 + 4 * n); w2[n] = *(const f32x4*)(cw + 2 * DFF + ch0 + 4 * n); bb[n] = *(const f32x4*)(cb + ch0 + 4 * n); }
#pragma unroll
        for (int ai = 0; ai < 2; ++ai) {
            f32x4 s1p[2], s2p[2];
#pragma unroll
            for (int n = 0; n < 2; ++n) { s1p[n] = (f32x4){0.f, 0.f, 0.f, 0.f}; s2p[n] = s1p[n]; }
#pragma unroll
            for (int m = 0; m < 4; ++m) {
                const int row = row0 + ai * 128 + m * 16, t = row & 31;
                u32x2 ow[2];
#pragma unroll
                for (int n = 0; n < 2; ++n) {
                    const pg8::f32x4 a = acc[ai][0][m][n], uu = acc[ai][1][m][n];
                    f32x4 s1, s2, o;
#pragma unroll
                    for (int j = 0; j < 4; ++j) { s1[j] = __shfl(a[j], L1); s2[j] = __shfl(a[j], L2); }
#pragma unroll
                    for (int j = 0; j < 4; ++j) {
                        const float p1 = fr >= 1 ? s1[j] : s1p[n][j], p2 = fr >= 2 ? s2[j] : s2p[n][j];
                        const float c = bb[n][j] + p2 * w0[n][j] + p1 * w1[n][j] + a[j] * w2[n][j];
                        o[j] = fsilu(c) * uu[j];
                    }
                    s1p[n] = s1; s2p[n] = s2;
                    ow[n].x = pk2(o[0], o[1]); ow[n].y = pk2(o[2], o[3]);
                }
                const bool inwave = (m == 2) && (u.pm < MP / 256);
                if (t >= 2 || inwave) *(u32x4*)(HG + (size_t)row * DFF + ch0) = (u32x4){ow[0].x, ow[0].y, ow[1].x, ow[1].y};
                if ((t < 2 && !inwave) || t >= 30) {
                    const pg8::f32x4 a0 = acc[ai][0][m][0], a1 = acc[ai][0][m][1];
                    bf16_t* sd = SIDE + ((size_t)(row >> 5) * 6 + (t >= 30 ? t - 30 : t + 2)) * DFF + ch0;
                    *(u32x4*)sd = (u32x4){pk2(a0[0], a0[1]), pk2(a0[2], a0[3]), pk2(a1[0], a1[1]), pk2(a1[2], a1[3])};
                    if (t < 2) { const pg8::f32x4 u0 = acc[ai][1][m][0], u1 = acc[ai][1][m][1];
                        *(u32x4*)(sd + 2 * DFF) = (u32x4){pk2(u0[0], u0[1]), pk2(u0[2], u0[3]), pk2(u1[0], u1[1]), pk2(u1[2], u1[3])}; }
                    float* dst = nullptr;
                    if (row < MP) { const int tq = row & 4095; if (tq >= 4094) dst = cp + ((size_t)(row >> 12) * 2 + (tq - 4094)) * DFF + ch0; }
                    else if (t >= 30) dst = cs + ((size_t)((row - MP) >> 5) * 2 + (t - 30)) * DFF + ch0;
                    if (dst) { *(f32x4*)dst = a0; *(f32x4*)(dst + 4) = a1; }
                }
            }
        }
    }
};
struct EpiBin {
    static constexpr bool PERM = true, AFTER_DRAIN = false;
    unsigned char* ws;
    __device__ __forceinline__ void operator()(const pg8::f32x4 (&acc)[2][2][4][2], const pg8::Unit& u, int wr, int wc, int fr, int fq) const {
        const int row0 = u.pm * 256 + wr * 64 + fr;
        if (u.pn >= 32) {
            const int col0 = (u.pn & 15) * 256 + wc * 32 + 8 * fq, sel = u.pn >> 4;
            bf16_t* dst = (bf16_t*)(ws + WS_Q + (size_t)sel * (136 * MiB));
#pragma unroll
            for (int ai = 0; ai < 2; ++ai)
#pragma unroll
                for (int m = 0; m < 4; ++m)
#pragma unroll
                    for (int bj = 0; bj < 2; ++bj) {
                        const pg8::f32x4 v0 = acc[ai][bj][m][0], v1 = acc[ai][bj][m][1];
                        u32x4 w; w.x = pk2(v0[0], v0[1]); w.y = pk2(v0[2], v0[3]); w.z = pk2(v1[0], v1[1]); w.w = pk2(v1[2], v1[3]);
                        *(u32x4*)(dst + (size_t)(row0 + ai * 128 + m * 16) * D + col0 + bj * 128) = w;
                    }
            return;
        }
        const int ch0 = u.pn * 128 + wc * 32 + 8 * fq;
        bf16_t* QS = (bf16_t*)(ws + WS_QS); bf16_t* KD = (bf16_t*)(ws + WS_KD); float* DCH = (float*)(ws + WS_DCH); const float* LB = (const float*)(ws + WS_LB);
        const f32x4 lb0 = *(const f32x4*)(LB + ch0), lb1 = *(const f32x4*)(LB + ch0 + 4);
        const int l15 = (fq * 16 + 15) * 4;
#pragma unroll
        for (int ai = 0; ai < 2; ++ai)
#pragma unroll
            for (int mp = 0; mp < 2; ++mp) {
                unsigned wq0[4], wq1[4], wk0[4], wk1[4];
#pragma unroll
                for (int n = 0; n < 2; ++n) {
                    const f32x4 lb = n ? lb1 : lb0;
                    float k0[4], k1[4], b0[4], b1[4];
#pragma unroll
                    for (int j = 0; j < 4; ++j) {
                        const float om = 1.0f - lb[j];
                        const float e0 = fexp(-acc[ai][1][2 * mp][n][j]), e1 = fexp(-acc[ai][1][2 * mp + 1][n][j]);
                        const float r0 = frcp(1.0f + e0), r1 = frcp(1.0f + e1);
                        k0[j] = om * e0 * r0; k1[j] = om * e1 * r1;
                        b0[j] = __builtin_amdgcn_logf(lb[j] + om * r0); b1[j] = __builtin_amdgcn_logf(lb[j] + om * r1);
                    }
#pragma unroll
                    for (int j = 0; j < 4; ++j) {
                        b0[j] += __int_as_float(__builtin_amdgcn_update_dpp(0, __float_as_int(b0[j]), 0x111, 0xf, 0xf, true));
                        b1[j] += __int_as_float(__builtin_amdgcn_update_dpp(0, __float_as_int(b1[j]), 0x111, 0xf, 0xf, true));
                    }
#pragma unroll
                    for (int j = 0; j < 4; ++j) {
                        b0[j] += __int_as_float(__builtin_amdgcn_update_dpp(0, __float_as_int(b0[j]), 0x112, 0xf, 0xf, true));
                        b1[j] += __int_as_float(__builtin_amdgcn_update_dpp(0, __float_as_int(b1[j]), 0x112, 0xf, 0xf, true));
                    }
#pragma unroll
                    for (int j = 0; j < 4; ++j) {
                        b0[j] += __int_as_float(__builtin_amdgcn_update_dpp(0, __float_as_int(b0[j]), 0x114, 0xf, 0xf, true));
                        b1[j] += __int_as_float(__builtin_amdgcn_update_dpp(0, __float_as_int(b1[j]), 0x114, 0xf, 0xf, true));
                    }
#pragma unroll
                    for (int j = 0; j < 4; ++j) {
                        b0[j] += __int_as_float(__builtin_amdgcn_update_dpp(0, __float_as_int(b0[j]), 0x118, 0xf, 0xf, true));
                        b1[j] += __int_as_float(__builtin_amdgcn_update_dpp(0, __float_as_int(b1[j]), 0x118, 0xf, 0xf, true));
                    }
                    float qs0[4], qs1[4], kd0[4], kd1[4]; f32x4 et;
#pragma unroll
                    for (int j = 0; j < 4; ++j) {
                        b1[j] += __int_as_float(__builtin_amdgcn_ds_bpermute(l15, __float_as_int(b0[j])));
                        const float eb0 = __builtin_amdgcn_exp2f(b0[j]), eb1 = __builtin_amdgcn_exp2f(b1[j]);
                        qs0[j] = acc[ai][0][2 * mp][n][j] * eb0; qs1[j] = acc[ai][0][2 * mp + 1][n][j] * eb1;
                        kd0[j] = k0[j] * frcp(eb0); kd1[j] = k1[j] * frcp(eb1);
                        et[j] = eb1;
                    }
                    wq0[2 * n] = pk2(qs0[0], qs0[1]); wq0[2 * n + 1] = pk2(qs0[2], qs0[3]); wq1[2 * n] = pk2(qs1[0], qs1[1]); wq1[2 * n + 1] = pk2(qs1[2], qs1[3]);
                    wk0[2 * n] = pk2(kd0[0], kd0[1]); wk0[2 * n + 1] = pk2(kd0[2], kd0[3]); wk1[2 * n] = pk2(kd1[0], kd1[1]); wk1[2 * n + 1] = pk2(kd1[2], kd1[3]);
                    if (fr == 15) *(f32x4*)(DCH + (size_t)(u.pm * 8 + ai * 4 + wr * 2 + mp) * D + ch0 + 4 * n) = et;
                }
                const size_t o0 = (size_t)(row0 + ai * 128 + mp * 32) * D + ch0, o1 = o0 + (size_t)16 * D;
                u32x4 w;
                w.x = wq0[0]; w.y = wq0[1]; w.z = wq0[2]; w.w = wq0[3]; *(u32x4*)(QS + o0) = w;
                w.x = wq1[0]; w.y = wq1[1]; w.z = wq1[2]; w.w = wq1[3]; *(u32x4*)(QS + o1) = w;
                w.x = wk0[0]; w.y = wk0[1]; w.z = wk0[2]; w.w = wk0[3]; *(u32x4*)(KD + o0) = w;
                w.x = wk1[0]; w.y = wk1[1]; w.z = wk1[2]; w.w = wk1[3]; *(u32x4*)(KD + o1) = w;
            }
    }
};

struct CvItem { const float* src; bf16_t* dst; int K, N; };
__device__ __forceinline__ void cv_load(const CvItem& d, int lane, f32x4 (&x)[16]) {
    const unsigned lo = (unsigned)((lane >> 4) * d.N + 4 * (lane & 15)) * 4u, step = (unsigned)d.N * 16u;
#pragma unroll
    for (int i = 0; i < 16; ++i) x[i] = __builtin_nontemporal_load((const f32x4*)((const char*)d.src + lo + (unsigned)i * step));
}
__device__ __forceinline__ void cv_store(const CvItem& d, int lane, const f32x4 (&x)[16], LAS float* scr) {
#pragma unroll
    for (int i = 0; i < 16; ++i) {
        LAS float* p = scr + (4 * i + (lane >> 4)) * 65 + 4 * (lane & 15);
        p[0] = x[i][0]; p[1] = x[i][1]; p[2] = x[i][2]; p[3] = x[i][3];
    }
    LDS_WAIT();
    const int c = lane & 7;
#pragma unroll
    for (int j = 0; j < 8; ++j) {
        const int n = (lane >> 3) + 8 * j; const LAS float* s = scr + (8 * c) * 65 + n;
        u32x4 o; o.x = pk2(s[0], s[65]); o.y = pk2(s[2 * 65], s[3 * 65]); o.z = pk2(s[4 * 65], s[5 * 65]); o.w = pk2(s[6 * 65], s[7 * 65]);
        __builtin_nontemporal_store(o, (u32x4*)((char*)d.dst + (unsigned)(n * d.K + 8 * c) * 2u));
    }
    LDS_WAIT();
}
constexpr int I_AIN = 64 * 128, I_AOUT = 64 * 64, I_BIN = 64 * 256, I_BOUT = 64 * 64, I_UP = 64 * 344, I_DN = 172 * 64;
constexpr int CV_DN0A = 7400, CV_UP0A = 6000;
constexpr int CV_S0 = 0;
constexpr int CV_S1 = CV_S0 + I_AIN + CV_DN0A;
constexpr int CV_S2 = CV_S1 + I_AOUT + CV_UP0A;
constexpr int CV_S3 = CV_S2 + (I_UP - CV_UP0A);
constexpr int CV_S4 = CV_S3 + (I_DN - CV_DN0A);
constexpr int CV_S4B = CV_S4 + I_BIN + I_BOUT + I_UP / 2;
constexpr int CV_S5 = CV_S4B + I_UP - I_UP / 2;
constexpr int CV_END = CV_S5 + I_DN;
__device__ __forceinline__ CvItem cv_decode(const Ctx& C, unsigned char* ws_, int it) {
    int r = it; const float* W; bf16_t* WT; int K, N, kind = 0;
    if (r < I_AIN) { W = inp(C, 4); WT = (bf16_t*)(ws_ + WS_W_AIN); K = D; N = NAIN; }
    else if ((r -= I_AIN) < CV_DN0A) { W = inp(C, 17); WT = (bf16_t*)(ws_ + WS_W_DN0); K = DFF; N = D; }
    else if ((r -= CV_DN0A) < I_AOUT) { W = inp(C, 9); WT = (bf16_t*)(ws_ + WS_W_AOUT); K = D; N = D; }
    else if ((r -= I_AOUT) < I_UP) { W = inp(C, 14); WT = (bf16_t*)(ws_ + WS_W_UP0); K = D; N = NUP; kind = 1; }
    else if ((r -= I_UP) < I_DN - CV_DN0A) { r += CV_DN0A; W = inp(C, 17); WT = (bf16_t*)(ws_ + WS_W_DN0); K = DFF; N = D; }
    else if ((r -= I_DN - CV_DN0A) < I_BIN) { W = inp(C, 10); WT = (bf16_t*)(ws_ + WS_W_BIN); K = D; N = NBIN; kind = 2; }
    else if ((r -= I_BIN) < I_BOUT) { W = inp(C, 13); WT = (bf16_t*)(ws_ + WS_W_BOUT); K = D; N = D; }
    else if ((r -= I_BOUT) < I_UP) { W = inp(C, 14) + (size_t)D * NUP; WT = (bf16_t*)(ws_ + WS_W_UP1); K = D; N = NUP; kind = 1; }
    else { r -= I_UP; W = inp(C, 17) + (size_t)DFF * D; WT = (bf16_t*)(ws_ + WS_W_DN1); K = DFF; N = D; }
    const int nblk = N / 64, kb = r / nblk, nb = r % nblk, n0 = nb * 64;
    int drow0 = n0;
    if (kind == 1) { const int h = n0 >= DFF ? 1 : 0, c = n0 - h * DFF; drow0 = 256 * (c >> 7) + 128 * h + (c & 127); }
    if (kind == 2 && n0 < 2 * D) { const int h = n0 >= D ? 1 : 0, c = n0 - h * D; drow0 = 256 * (c >> 7) + 128 * h + (c & 127); }
    CvItem d; d.src = W + (size_t)(kb * 64) * N + n0; d.dst = WT + (size_t)drow0 * K + kb * 64; d.K = K; d.N = N; return d;
}
__device__ __forceinline__ void conv_range(const Ctx& C, int lo, int hi, int rank, int nranks) {
    unsigned char* const ws_ = wsp(C);
    LAS float* scr = (LAS float*)(C.lds + C.wave * 16640);
    int it = lo + rank;
    if (it >= hi) return;
    CvItem d = cv_decode(C, ws_, it); f32x4 cur[16], nxt[16];
    cv_load(d, C.lane, cur);
    for (;;) {
        const int itn = it + nranks; const bool more = itn < hi;
        CvItem dn = d;
        if (more) { dn = cv_decode(C, ws_, itn); cv_load(dn, C.lane, nxt); }
        cv_store(d, C.lane, cur, scr);
        if (!more) break;
#pragma unroll
        for (int i = 0; i < 16; ++i) cur[i] = nxt[i];
        d = dn; it = itn;
    }
}
__device__ __forceinline__ void conv_queue(const Ctx& C, int seg, int lo, int hi) {
    unsigned char* const ws_ = wsp(C);
    unsigned* ctr = (unsigned*)(ws_ + WS_CTL) + CW_CV + seg * 64;
    LAS float* scr = (LAS float*)(C.lds + C.wave * 16640);
    for (;;) {
        unsigned t = 0; if (C.lane == 0) t = __hip_atomic_fetch_add(ctr, 1u, __ATOMIC_RELAXED, __HIP_MEMORY_SCOPE_AGENT);
        t = (unsigned)__builtin_amdgcn_readfirstlane((int)t);
        const int it0 = lo + (int)t * 4; if (it0 >= hi) break;
        for (int it = it0; it < it0 + 4 && it < hi; ++it) { const CvItem d = cv_decode(C, ws_, it); f32x4 x[16]; cv_load(d, C.lane, x); cv_store(d, C.lane, x, scr); }
    }
    __syncthreads();
}
__device__ __forceinline__ void conv_tail(const Ctx& C, int nwg, int lo, int hi) {
    const int R = (nwg + C.G - 1) / C.G - 1, nbusy = nwg - R * C.G;
    if (nbusy >= C.G) conv_range(C, lo, hi, C.bid * 8 + C.wave, C.G * 8);
    else if (C.bid >= nbusy) conv_range(C, lo, hi, (C.bid - nbusy) * 8 + C.wave, (C.G - nbusy) * 8);
    __syncthreads();
}
__device__ __forceinline__ void p0_prologue(const Ctx& C0) {
    const Ctx C = C0;
    unsigned char* const ws_ = wsp(C);
    conv_range(C, CV_S0, CV_S1, C.bid * 8 + C.wave, C.G * 8);
    bf16_t* XB = (bf16_t*)(ws_ + WS_XB); const float* const xp_ = inp(C, 0); const float* const xs_ = inp(C, 1);
    for (size_t i = (size_t)C.bid * 512 + C.tid; i < (size_t)M * D / 8; i += (size_t)C.G * 512) {
        const int row = (int)(i >> 9), c8 = (int)(i & 511);
        const float* xr = xin_row(xp_, xs_, row) + c8 * 8;
        const f32x4 a = *(const f32x4*)xr, b = *(const f32x4*)(xr + 4);
        u32x4 w; w.x = pk2(a[0], a[1]); w.y = pk2(a[2], a[3]); w.z = pk2(b[0], b[1]); w.w = pk2(b[2], b[3]);
        *(u32x4*)(XB + (size_t)row * D + c8 * 8) = w;
    }
    float* LB = (float*)(ws_ + WS_LB);
    const float* const blb_ = inp(C, 11);
    for (int i = C.bid * 512 + C.tid; i < D; i += C.G * 512) { const float b0 = blb_[i], b1 = blb_[D + i]; LB[i] = 1.0f / (1.0f + expf(b0 - b1)); }
}

__device__ __forceinline__ void p_rowstat(const Ctx& C0) {
    const Ctx C = C0;
    unsigned char* const ws_ = wsp(C);
    const f32x2* stat = (const f32x2*)(ws_ + WS_STAT); f32x2* rs = (f32x2*)(ws_ + WS_ROWSTAT);
    for (int row = C.bid * 8 + C.wave; row < M; row += C.G * 8) {
        const f32x2 sl = stat[(size_t)row * 64 + C.lane];
        const float s1 = wave_sum(sl[0]), s2 = wave_sum(sl[1]);
        const float mean = s1 * (1.0f / D), var = s2 * (1.0f / D) - mean * mean;
        if (C.lane == 0) rs[row] = (f32x2){mean, 1.0f / sqrtf(var + LN_EPS)};
    }
}
__device__ __forceinline__ void p_ln_apply(const Ctx& C0, const float* g, const float* b, bf16_t* XBo, float* Yo) {
    const Ctx C = C0;
    unsigned char* const ws_ = wsp(C);
    const bf16_t* H = (const bf16_t*)(ws_ + WS_H32); const f32x2* stat = (const f32x2*)(ws_ + WS_STAT); f32x2* rs2 = (f32x2*)(ws_ + WS_RS2);
    const unsigned loff = (unsigned)C.lane * 16u;
    for (int row = C.bid * 8 + C.wave; row < M; row += C.G * 8) {
        const f32x2 sl = stat[(size_t)row * 64 + C.lane];
        const bf16_t* hr = H + (size_t)row * D;
        u32x4 hw[8];
#pragma unroll
        for (int j = 0; j < 8; ++j) hw[j] = ldo<u32x4>(hr, loff + (unsigned)j * 1024u);
        const float s1 = wave_sum(sl[0]), s2 = wave_sum(sl[1]);
        const float mean = s1 * (1.0f / D), var = s2 * (1.0f / D) - mean * mean, rstd = 1.0f / sqrtf(var + LN_EPS);
        if (C.lane == 0) rs2[row] = (f32x2){mean, rstd};
#pragma unroll
        for (int j = 0; j < 8; ++j) {
            const int c = 512 * j + 8 * C.lane;
            const f32x4 v0 = {bflo(hw[j].x), bfhi(hw[j].x), bflo(hw[j].y), bfhi(hw[j].y)}, v1 = {bflo(hw[j].z), bfhi(hw[j].z), bflo(hw[j].w), bfhi(hw[j].w)};
            const f32x4 g0 = *(const f32x4*)(g + c), g1 = *(const f32x4*)(g + c + 4), b0 = *(const f32x4*)(b + c), b1 = *(const f32x4*)(b + c + 4);
            const f32x4 y0 = (v0 - mean) * rstd * g0 + b0, y1 = (v1 - mean) * rstd * g1 + b1;
            if (Yo) { __builtin_nontemporal_store(y0, (f32x4*)(Yo + (size_t)row * D + c)); __builtin_nontemporal_store(y1, (f32x4*)(Yo + (size_t)row * D + c + 4)); }
            if (XBo) { u32x4 w; w.x = pk2(y0[0], y0[1]); w.y = pk2(y0[2], y0[3]); w.z = pk2(y1[0], y1[1]); w.w = pk2(y1[2], y1[3]); *(u32x4*)(XBo + (size_t)row * D + c) = w; }
        }
    }
}
__device__ __forceinline__ void p_convfix(const Ctx& C0, int layer) {
    const Ctx C = C0;
    unsigned char* const ws_ = wsp(C);
    const bf16_t* SIDE = (const bf16_t*)(ws_ + WS_SIDE); bf16_t* HG = (bf16_t*)(ws_ + WS_HG);
    const float* cw = inp(C, 15) + (size_t)layer * 3 * DFF; const float* cb = inp(C, 16) + (size_t)layer * DFF;
    const float* cache = inp(C, 3) + (size_t)layer * 32 * 2 * DFF;
    constexpr int NCH = DFF / 8, NCK = MP / 64 + (M - MP) / 32;
    for (int task = C.bid * 512 + C.tid; task < NCK * NCH; task += C.G * 512) {
        const int ki = task / NCH, q = task - ki * NCH, c = 8 * q, k = ki < MP / 64 ? 2 * ki : MP / 32 + (ki - MP / 64);
        float w0[8], w1[8], w2[8], bb[8], p1[8], p2[8], a0[8], a1[8], u0[8], u1[8];
#pragma unroll
        for (int j = 0; j < 8; ++j) { w0[j] = cw[c + j]; w1[j] = cw[DFF + c + j]; w2[j] = cw[2 * DFF + c + j]; bb[j] = cb[c + j]; p1[j] = 0.f; p2[j] = 0.f; }
        if (k >= MP / 32) {
            const float* cs = cache + (size_t)(k - MP / 32) * 2 * DFF + c;
#pragma unroll
            for (int j = 0; j < 8; ++j) { p2[j] = cs[j]; p1[j] = cs[DFF + j]; }
        } else if ((k & 127) != 0) {
            const u32x4 x2 = *(const u32x4*)(SIDE + ((size_t)(k - 1) * 6 + 0) * DFF + c), x1 = *(const u32x4*)(SIDE + ((size_t)(k - 1) * 6 + 1) * DFF + c);
#pragma unroll
            for (int j = 0; j < 4; ++j) { p2[2 * j] = bflo(x2[j]); p2[2 * j + 1] = bfhi(x2[j]); p1[2 * j] = bflo(x1[j]); p1[2 * j + 1] = bfhi(x1[j]); }
        }
        const bf16_t* sd = SIDE + (size_t)k * 6 * DFF + c;
        const u32x4 xa0 = *(const u32x4*)(sd + 2 * DFF), xa1 = *(const u32x4*)(sd + 3 * DFF), xu0 = *(const u32x4*)(sd + 4 * DFF), xu1 = *(const u32x4*)(sd + 5 * DFF);
#pragma unroll
        for (int j = 0; j < 4; ++j) { a0[2 * j] = bflo(xa0[j]); a0[2 * j + 1] = bfhi(xa0[j]); a1[2 * j] = bflo(xa1[j]); a1[2 * j + 1] = bfhi(xa1[j]);
                                       u0[2 * j] = bflo(xu0[j]); u0[2 * j + 1] = bfhi(xu0[j]); u1[2 * j] = bflo(xu1[j]); u1[2 * j + 1] = bfhi(xu1[j]); }
        float o0[8], o1[8];
#pragma unroll
        for (int j = 0; j < 8; ++j) {
            const float c0 = bb[j] + p2[j] * w0[j] + p1[j] * w1[j] + a0[j] * w2[j];
            const float c1 = bb[j] + p1[j] * w0[j] + a0[j] * w1[j] + a1[j] * w2[j];
            o0[j] = fsilu(c0) * u0[j]; o1[j] = fsilu(c1) * u1[j];
        }
        *(u32x4*)(HG + (size_t)(32 * k) * DFF + c) = (u32x4){pk2(o0[0], o0[1]), pk2(o0[2], o0[3]), pk2(o0[4], o0[5]), pk2(o0[6], o0[7])};
        *(u32x4*)(HG + (size_t)(32 * k + 1) * DFF + c) = (u32x4){pk2(o1[0], o1[1]), pk2(o1[2], o1[3]), pk2(o1[4], o1[5]), pk2(o1[6], o1[7])};
    }
}

constexpr int SG_WS = 0, SG_VN = 34816, SG_MX = 69632, SG_ROW = 272, SG_MXROW = 528;
__device__ __forceinline__ void p_spatial(const Ctx& C0) {
    const Ctx C = C0;
    unsigned char* const ws_ = wsp(C); float* const out_ = outp(C);
    const bf16_t* Z = (const bf16_t*)(ws_ + WS_Z); bf16_t* GATED = (bf16_t*)(ws_ + WS_GATED);
    const f32x2* rs = (const f32x2*)(ws_ + WS_ROWSTAT);
    const float* w_s = inp(C, 7); const float* b_s = inp(C, 8); const float* ln_g = inp(C, 5); const float* ln_b = inp(C, 6);
    LAS unsigned char* lds = C.lds;
    const int tid = C.tid, lane = C.lane, wave = C.wave, wr = wave >> 2, wc = wave & 3, c16 = lane & 15, hh = lane >> 4, q4 = (lane & 15) >> 2, p4 = lane & 3;
    int cur_g = -1, cur_type = -1;
    float lg[8], lbv[8], bsv[4];
    for (int u = C.bid; u < (M / 128) * 32; u += C.G) {
        const int rb = u >> 5, g = u & 31, r0 = rb * 128, type = (r0 >= MP) ? 1 : 0;
        u32x4 U16[4], V16[4]; f32x2 st[4];
        const int c8 = tid & 15;
#pragma unroll
        for (int k = 0; k < 4; ++k) {
            const int t = (tid >> 4) + 32 * k;
            const bf16_t* zr = Z + (size_t)(r0 + t) * NAIN + g * 128 + c8 * 8;
            U16[k] = *(const u32x4*)zr; V16[k] = *(const u32x4*)(zr + D); st[k] = rs[r0 + t];
        }
        if (g != cur_g || type != cur_type) {
            __syncthreads();
            const int t = tid >> 2, sq = tid & 3;
#pragma unroll
            for (int s8 = 0; s8 < 4; ++s8) {
                const int s0 = 32 * sq + 8 * s8; float wv[8];
                if (type == 0) {
                    const float* src = w_s + ((size_t)g * 128 + t) * 128 + s0;
                    const f32x4 a = *(const f32x4*)src, b = *(const f32x4*)(src + 4);
#pragma unroll
                    for (int j = 0; j < 4; ++j) { wv[j] = (s0 + j <= t) ? a[j] : 0.f; wv[4 + j] = (s0 + 4 + j <= t) ? b[j] : 0.f; }
                } else {
                    const int tl = t & 31, sl = s0 & 31; const bool same = (t >> 5) == (s0 >> 5);
                    const float* src = w_s + ((size_t)g * 128 + tl) * 128 + sl;
                    const f32x4 a = *(const f32x4*)src, b = *(const f32x4*)(src + 4);
#pragma unroll
                    for (int j = 0; j < 4; ++j) { wv[j] = (same && sl + j <= tl) ? a[j] : 0.f; wv[4 + j] = (same && sl + 4 + j <= tl) ? b[j] : 0.f; }
                }
                u32x4 w; w.x = pk2(wv[0], wv[1]); w.y = pk2(wv[2], wv[3]); w.z = pk2(wv[4], wv[5]); w.w = pk2(wv[6], wv[7]);
                *(LAS u32x4*)(lds + SG_WS + t * SG_ROW + s0 * 2) = w;
            }
#pragma unroll
            for (int j = 0; j < 8; ++j) { lg[j] = ln_g[g * 128 + c8 * 8 + j]; lbv[j] = ln_b[g * 128 + c8 * 8 + j]; }
#pragma unroll
            for (int tt = 0; tt < 4; ++tt) { const int t2 = 64 * wr + 16 * tt + c16; bsv[tt] = b_s[g * 128 + (type ? (t2 & 31) : t2)]; }
            cur_g = g; cur_type = type;
        }
#pragma unroll
        for (int k = 0; k < 4; ++k) {
            const int t = (tid >> 4) + 32 * k; float vn[8];
#pragma unroll
            for (int j = 0; j < 4; ++j) {
                vn[2 * j] = (bflo(V16[k][j]) - st[k][0]) * st[k][1] * lg[2 * j] + lbv[2 * j];
                vn[2 * j + 1] = (bfhi(V16[k][j]) - st[k][0]) * st[k][1] * lg[2 * j + 1] + lbv[2 * j + 1];
            }
            if (type) { float* nv = out_ + OUT_NV + (size_t)(r0 + t - MP) * D + g * 128 + c8 * 8;
                *(f32x4*)nv = (f32x4){vn[0], vn[1], vn[2], vn[3]}; *(f32x4*)(nv + 4) = (f32x4){vn[4], vn[5], vn[6], vn[7]}; }
            u32x4 w; w.x = pk2(vn[0], vn[1]); w.y = pk2(vn[2], vn[3]); w.z = pk2(vn[4], vn[5]); w.w = pk2(vn[6], vn[7]);
            *(LAS u32x4*)(lds + SG_VN + t * SG_ROW + c8 * 16) = w;
        }
        __syncthreads();
        f32x4 acc[2][4];
#pragma unroll
        for (int ct = 0; ct < 2; ++ct)
#pragma unroll
            for (int tt = 0; tt < 4; ++tt) acc[ct][tt] = (f32x4){0.f, 0.f, 0.f, 0.f};
#pragma unroll
        for (int kk = 0; kk < 4; ++kk) {
            bf16x8 a[2], b[4];
#pragma unroll
            for (int ct = 0; ct < 2; ++ct) {
                LAS unsigned char* p = lds + SG_VN + (32 * kk + 8 * hh + q4) * SG_ROW + (32 * wc + 16 * ct + 4 * p4) * 2;
                a[ct] = cat4(lds_tr(p), lds_tr(p + 4 * SG_ROW));
            }
#pragma unroll
            for (int tt = 0; tt < 4; ++tt) b[tt] = *(const LAS bf16x8*)(lds + SG_WS + (64 * wr + 16 * tt + c16) * SG_ROW + (32 * kk + 8 * hh) * 2);
#pragma unroll
            for (int ct = 0; ct < 2; ++ct)
#pragma unroll
                for (int tt = 0; tt < 4; ++tt) acc[ct][tt] = __builtin_amdgcn_mfma_f32_16x16x32_bf16(a[ct], b[tt], acc[ct][tt], 0, 0, 0);
        }
#pragma unroll
        for (int ct = 0; ct < 2; ++ct)
#pragma unroll
            for (int tt = 0; tt < 4; ++tt)
                *(LAS f32x4*)(lds + SG_MX + (64 * wr + 16 * tt + c16) * SG_MXROW + (32 * wc + 16 * ct + 4 * hh) * 4) = acc[ct][tt] + bsv[tt];
        __syncthreads();
#pragma unroll
        for (int k = 0; k < 4; ++k) {
            const int t = (tid >> 4) + 32 * k;
            const f32x4 m0 = *(const LAS f32x4*)(lds + SG_MX + t * SG_MXROW + c8 * 32), m1 = *(const LAS f32x4*)(lds + SG_MX + t * SG_MXROW + c8 * 32 + 16);
            u32x4 w;
            w.x = pk2(bflo(U16[k][0]) * m0[0], bfhi(U16[k][0]) * m0[1]); w.y = pk2(bflo(U16[k][1]) * m0[2], bfhi(U16[k][1]) * m0[3]);
            w.z = pk2(bflo(U16[k][2]) * m1[0], bfhi(U16[k][2]) * m1[1]); w.w = pk2(bflo(U16[k][3]) * m1[2], bfhi(U16[k][3]) * m1[3]);
            *(u32x4*)(GATED + (size_t)(r0 + t) * D + g * 128 + c8 * 8) = w;
        }
    }
    __syncthreads();
}


#ifndef GLA_PROMPT_REPS
#define GLA_PROMPT_REPS 1
#endif
constexpr int GL_QS = 0, GL_KD = 8704, GL_V = 17408, GL_G = 26112, GL_DCH = 34816, GL_BUF = 35328, GL_OT = 2 * GL_BUF, GL_OTSZ = 32 * 528, GL_ROW = 272, GL_OTROW = 528;
#define GLA_NORM(PK, GATE) do { const int pk_ = (PK); \
            LAS unsigned char* OTp = lds + GL_OT + (pk_ & 1) * GL_OTSZ; const int orow = 4 * w + hh; \
            const f32x4 x0 = *(const LAS f32x4*)(OTp + orow * GL_OTROW + c16 * 32), x1 = *(const LAS f32x4*)(OTp + orow * GL_OTROW + c16 * 32 + 16); \
            float ss = x0[0] * x0[0] + x0[1] * x0[1] + x0[2] * x0[2] + x0[3] * x0[3] + x1[0] * x1[0] + x1[1] * x1[1] + x1[2] * x1[2] + x1[3] * x1[3]; \
            ss += __shfl_xor(ss, 1); ss += __shfl_xor(ss, 2); ss += __shfl_xor(ss, 4); ss += __shfl_xor(ss, 8); \
            const float rn = 1.0f / sqrtf(ss * (1.0f / 128.0f) + RMS_EPS); \
            u32x4 wv; \
            wv.x = pk2(x0[0] * rn * g0[0] * fsilu(bflo(GATE[0])), x0[1] * rn * g0[1] * fsilu(bfhi(GATE[0]))); \
            wv.y = pk2(x0[2] * rn * g0[2] * fsilu(bflo(GATE[1])), x0[3] * rn * g0[3] * fsilu(bfhi(GATE[1]))); \
            wv.z = pk2(x1[0] * rn * g1[0] * fsilu(bflo(GATE[2])), x1[1] * rn * g1[1] * fsilu(bfhi(GATE[2]))); \
            wv.w = pk2(x1[2] * rn * g1[2] * fsilu(bflo(GATE[3])), x1[3] * rn * g1[3] * fsilu(bfhi(GATE[3]))); \
            sto<u32x4>(O + (size_t)(rbase + 32 * pk_) * D + cb, ooff, wv); } while (0)
#define GLA_STEP(CKV, WRSET, LDSET) do { const int ck = (CKV); \
            LAS unsigned char* B = lds + (ck & 1) * GL_BUF; \
            LAS unsigned char* OT = lds + GL_OT + (ck & 1) * GL_OTSZ; \
            const int r0 = rbase + 32 * ck; \
            const bool more = ck + 1 < nck; \
            const size_t uo = (size_t)r0 * D + cb; \
            { const int c2 = ck + 2 < nck ? ck + 2 : nck - 1;     \
              const size_t u2 = (size_t)(rbase + 32 * c2) * D + cb; LDSET##a = ldo<u32x4>(QS + u2, soff); LDSET##b = ldo<u32x4>(KD + u2, soff); LDSET##d = ldo<u32x4>(V + u2, soff); LDSET##e = ldo<u32x4>(Gt + u2, soff); \
              if (w == 0) LDSET##f = ldo<f32x4>(DCH + (size_t)((rbase >> 5) + c2) * D + cb, (unsigned)(tid & 31) * 16u); }     \
            f32x4 dch[8]; \
_Pragma("unroll") \
            for (int i = 0; i < 8; ++i) dch[i] = *(const LAS f32x4*)(B + GL_DCH + (16 * i + 4 * hh) * 4); \
            f32x4 a00 = {0.f, 0.f, 0.f, 0.f}, a01 = a00, a11 = a00; \
_Pragma("unroll") \
            for (int kk = 0; kk < 4; ++kk) { \
                const int co = (32 * kk + 8 * hh) * 2; \
                const bf16x8 k0 = *(const LAS bf16x8*)(B + GL_KD + c16 * GL_ROW + co), k1 = *(const LAS bf16x8*)(B + GL_KD + (16 + c16) * GL_ROW + co); \
                const bf16x8 q0 = *(const LAS bf16x8*)(B + GL_QS + c16 * GL_ROW + co), q1 = *(const LAS bf16x8*)(B + GL_QS + (16 + c16) * GL_ROW + co); \
                a00 = __builtin_amdgcn_mfma_f32_16x16x32_bf16(k0, q0, a00, 0, 0, 0); \
                a01 = __builtin_amdgcn_mfma_f32_16x16x32_bf16(k0, q1, a01, 0, 0, 0); \
                a11 = __builtin_amdgcn_mfma_f32_16x16x32_bf16(k1, q1, a11, 0, 0, 0); \
            } \
            if (ck > 0) GLA_NORM(ck - 1, gprev); \
            gprev = *(const LAS u32x4*)(B + GL_G + (4 * w + hh) * GL_ROW + c16 * 16); \
_Pragma("unroll") \
            for (int r = 0; r < 4; ++r) { if (4 * hh + r > c16) { a00[r] = 0.f; a11[r] = 0.f; } } \
            bf16x8 P0, P1; \
            { u32x4 t; t.x = pk2(a00[0], a00[1]); t.y = pk2(a00[2], a00[3]); t.z = 0u; t.w = 0u; P0 = __builtin_bit_cast(bf16x8, t); } \
            { u32x4 t; t.x = pk2(a01[0], a01[1]); t.y = pk2(a01[2], a01[3]); t.z = pk2(a11[0], a11[1]); t.w = pk2(a11[2], a11[3]); P1 = __builtin_bit_cast(bf16x8, t); } \
            LAS unsigned char* vp = B + GL_V + (4 * hh + q4) * GL_ROW + (16 * w + 4 * p4) * 2; \
            const bf16x8 vB = cat4(lds_tr(vp), lds_tr(vp + 16 * GL_ROW)); \
            f32x4 o0 = {0.f, 0.f, 0.f, 0.f}, o1 = o0; \
            o0 = __builtin_amdgcn_mfma_f32_16x16x32_bf16(P0, vB, o0, 0, 0, 0); \
            o1 = __builtin_amdgcn_mfma_f32_16x16x32_bf16(P1, vB, o1, 0, 0, 0); \
_Pragma("unroll") \
            for (int kk = 0; kk < 4; ++kk) { \
                u32x4 sb; sb.x = pk2(S[2 * kk][0], S[2 * kk][1]); sb.y = pk2(S[2 * kk][2], S[2 * kk][3]); sb.z = pk2(S[2 * kk + 1][0], S[2 * kk + 1][1]); sb.w = pk2(S[2 * kk + 1][2], S[2 * kk + 1][3]); \
                const bf16x8 bS = __builtin_bit_cast(bf16x8, sb); \
                const int co = (32 * kk + 4 * hh) * 2; \
                const s16x4 x0 = *(const LAS s16x4*)(B + GL_QS + c16 * GL_ROW + co), x1 = *(const LAS s16x4*)(B + GL_QS + c16 * GL_ROW + co + 32); \
                const s16x4 y0 = *(const LAS s16x4*)(B + GL_QS + (16 + c16) * GL_ROW + co), y1 = *(const LAS s16x4*)(B + GL_QS + (16 + c16) * GL_ROW + co + 32); \
                o0 = __builtin_amdgcn_mfma_f32_16x16x32_bf16(cat4(x0, x1), bS, o0, 0, 0, 0); \
                o1 = __builtin_amdgcn_mfma_f32_16x16x32_bf16(cat4(y0, y1), bS, o1, 0, 0, 0); \
            } \
            { \
                LAS unsigned char* vq = B + GL_V + (8 * hh + q4) * GL_ROW + (16 * w + 4 * p4) * 2; \
                const bf16x8 vN = cat4(lds_tr(vq), lds_tr(vq + 4 * GL_ROW)); \
_Pragma("unroll") \
                for (int i = 0; i < 8; ++i) { \
                    LAS unsigned char* kp = B + GL_KD + (8 * hh + q4) * GL_ROW + (16 * i + 4 * p4) * 2; \
                    const bf16x8 kA = cat4(lds_tr(kp), lds_tr(kp + 4 * GL_ROW)); \
                    S[i] = __builtin_amdgcn_mfma_f32_16x16x32_bf16(kA, vN, S[i], 0, 0, 0) * dch[i]; \
                } \
            } \
_Pragma("unroll") \
            for (int r = 0; r < 4; ++r) { \
                *(LAS float*)(OT + (4 * hh + r) * GL_OTROW + (16 * w + c16) * 4) = o0[r]; \
                *(LAS float*)(OT + (16 + 4 * hh + r) * GL_OTROW + (16 * w + c16) * 4) = o1[r]; \
            } \
            { \
                LAS unsigned char* dst = lds + ((ck + 1) & 1) * GL_BUF + srow * GL_ROW + sch * 16; \
                *(LAS u32x4*)(dst + GL_QS) = WRSET##a; *(LAS u32x4*)(dst + GL_KD) = WRSET##b; *(LAS u32x4*)(dst + GL_V) = WRSET##d; *(LAS u32x4*)(dst + GL_G) = WRSET##e; \
                if (tid < 32) *(LAS f32x4*)(lds + ((ck + 1) & 1) * GL_BUF + GL_DCH + tid * 16) = WRSET##f; \
            } \
            __syncthreads(); \
        } while (0)
__device__ __forceinline__ void p_gla(const Ctx& C0) {
    const Ctx C = C0;
    unsigned char* const ws_ = wsp(C); float* const out_ = outp(C);
    const bf16_t* QS = (const bf16_t*)(ws_ + WS_QS); const bf16_t* KD = (const bf16_t*)(ws_ + WS_KD);
    const bf16_t* V = (const bf16_t*)(ws_ + WS_V); const bf16_t* Gt = (const bf16_t*)(ws_ + WS_G); const float* DCH = (const float*)(ws_ + WS_DCH);
    bf16_t* O = (bf16_t*)(ws_ + WS_O); const float* gn_g = inp(C, 12); const float* S0in = inp(C, 2);
    LAS unsigned char* lds = C.lds;
    const int tid = C.tid, lane = C.lane, w = C.wave, c16 = lane & 15, hh = lane >> 4, q4 = (lane & 15) >> 2, p4 = lane & 3;
    const int srow = tid >> 4, sch = tid & 15;
    const unsigned soff = (unsigned)(srow * D + sch * 8) * 2u;
    const unsigned ooff = (unsigned)((4 * w + hh) * D + c16 * 8) * 2u;
    const unsigned stoff = (unsigned)(4 * hh * 128 + 16 * w + c16) * 4u;
    const int NPI = 128, NSI = 1024, half = C.G >= 256 ? 128 : 0;
    for (int it = 0;; ++it) {
        int item;
        if (half) { if (C.bid < half) { if (it > GLA_PROMPT_REPS - 1) break; item = C.bid; } else { item = NPI + (C.bid - half) + it * (C.G - half); if (item >= NPI + NSI) break; } }
        else { item = C.bid + it * C.G; if (item >= NPI + NSI) break; }
        int rbase, h, nck; float* Sout; const float* Sin = nullptr;
        if (item < NPI) { const int b = item >> 5; h = item & 31; rbase = b * 4096; nck = 128; Sout = out_ + OUT_SP + (size_t)item * 16384; }
        else { const int si = item - NPI, s = si >> 5; h = si & 31; rbase = MP + s * 32; nck = 1; Sout = out_ + OUT_SS + (size_t)si * 16384; Sin = S0in + (size_t)si * 16384; }
        const int cb = h * 128;
        f32x4 S[8];
#pragma unroll
        for (int i = 0; i < 8; ++i) {
            if (Sin) {
#pragma unroll
                for (int r = 0; r < 4; ++r) S[i][r] = ldo<float>(Sin + (16 * i + r) * 128, stoff);
            } else S[i] = (f32x4){0.f, 0.f, 0.f, 0.f};
        }
        __syncthreads();
        {
            const size_t u0 = (size_t)rbase * D + cb;
            const u32x4 a = ldo<u32x4>(QS + u0, soff), b = ldo<u32x4>(KD + u0, soff), d = ldo<u32x4>(V + u0, soff), e = ldo<u32x4>(Gt + u0, soff);
            LAS unsigned char* dst = lds + srow * GL_ROW + sch * 16;
            *(LAS u32x4*)(dst + GL_QS) = a; *(LAS u32x4*)(dst + GL_KD) = b; *(LAS u32x4*)(dst + GL_V) = d; *(LAS u32x4*)(dst + GL_G) = e;
            if (tid < 32) *(LAS f32x4*)(lds + GL_DCH + tid * 16) = ldo<f32x4>(DCH + (size_t)(rbase >> 5) * D + cb, (unsigned)tid * 16u);
        }
        __syncthreads();
        const f32x4 g0 = ldo<f32x4>(gn_g + cb, (unsigned)c16 * 32u), g1 = ldo<f32x4>(gn_g + cb, (unsigned)c16 * 32u + 16u);
        u32x4 RAa, RAb, RAd, RAe, RBa, RBb, RBd, RBe; f32x4 RAf = {0.f, 0.f, 0.f, 0.f}, RBf = RAf;
        { const int c1 = nck > 1 ? 1 : 0; const size_t u1 = (size_t)(rbase + 32 * c1) * D + cb; RAa = ldo<u32x4>(QS + u1, soff); RAb = ldo<u32x4>(KD + u1, soff); RAd = ldo<u32x4>(V + u1, soff); RAe = ldo<u32x4>(Gt + u1, soff);
            if (w == 0) RAf = ldo<f32x4>(DCH + (size_t)((rbase >> 5) + c1) * D + cb, (unsigned)(tid & 31) * 16u); }
        u32x4 gprev = {0u, 0u, 0u, 0u};
        for (int ck2 = 0; ck2 < nck; ck2 += 2) {
            GLA_STEP(ck2, RA, RB);
            if (ck2 + 1 < nck) GLA_STEP(ck2 + 1, RB, RA);
        }
        GLA_NORM(nck - 1, gprev);
#pragma unroll
        for (int i = 0; i < 8; ++i)
#pragma unroll
            for (int r = 0; r < 4; ++r) sto<float>(Sout + (16 * i + r) * 128, stoff, S[i][r]);
    }
    __syncthreads();
    conv_queue(C, 5, CV_S4B, CV_S5);
}
#define PHASE_FN __device__ __forceinline__ void
PHASE_FN ph_prologue() { const Ctx C = make_ctx(); p0_prologue(C); }
PHASE_FN ph_gemm_ain() {
    const Ctx C = make_ctx(); unsigned char* const ws_ = wsp(C);
    pg8::Gemm g{(const bf16_t*)(ws_ + WS_XB), (const bf16_t*)(ws_ + WS_W_AIN), M, NAIN, D}; const QueueOrder S = make_queue(C, ws_, 0, M, NAIN);
    EpiGelu E{(bf16_t*)(ws_ + WS_Z), (float*)(ws_ + WS_STAT)};
    pg8::gemm_phase<EpiGelu, QueueOrder, true, true>(C.lds, g, S, E);
    conv_queue(C, 1, CV_S1, CV_S2);
}
#ifdef PROBE_NULL
PHASE_FN ph_probe() {
    const Ctx C = make_ctx(); unsigned char* const ws_ = wsp(C); float* const out_ = outp(C);
    pg8::Gemm g{(const bf16_t*)(ws_ + WS_XB), (const bf16_t*)(ws_ + WS_W_UP0), M, NUP, D}; const QueueOrder S = make_queue(C, ws_, 4 + L, M, NUP);
#if PROBE_NULL == 1
    EpiNull E{(float*)(ws_ + WS_SLAB)};
    pg8::gemm_phase<EpiNull, pg8::StaticOrder, true, true>(C.lds, g, S, E);
#else
    EpiUpConv E{(bf16_t*)(ws_ + WS_HG), (bf16_t*)(ws_ + WS_SIDE), out_ + OUT_CP, out_ + OUT_CS, inp(C, 15), inp(C, 16)};
    pg8::gemm_phase<EpiUpConv, pg8::StaticOrder, true, true>(C.lds, g, S, E);
#endif
}
#endif
PHASE_FN ph_rowstat() { const Ctx C = make_ctx(); p_rowstat(C); }
PHASE_FN ph_spatial() { const Ctx C = make_ctx(); p_spatial(C); }
PHASE_FN ph_gemm_bin() {
    const Ctx C = make_ctx(); unsigned char* const ws_ = wsp(C);
    pg8::Gemm g{(const bf16_t*)(ws_ + WS_XB), (const bf16_t*)(ws_ + WS_W_BIN), M, NBIN, D}; const QueueOrder S = make_queue(C, ws_, 1, M, NBIN);
    EpiBin E{ws_};
    pg8::gemm_phase<EpiBin, QueueOrder, true, true>(C.lds, g, S, E);
}
PHASE_FN ph_gla() { const Ctx C = make_ctx(); p_gla(C); }
template <int L> PHASE_FN ph_gemm_out() {
    const Ctx C = make_ctx(); unsigned char* const ws_ = wsp(C);
    pg8::Gemm g{(const bf16_t*)(ws_ + (L == 0 ? WS_GATED : WS_O)), (const bf16_t*)(ws_ + (L == 0 ? WS_W_AOUT : WS_W_BOUT)), M, D, D}; const QueueOrder S = make_queue(C, ws_, 2 + L, M, D);
    EpiRes<L == 0 ? 0 : 1> E{L == 0 ? inp(C, 0) : nullptr, L == 0 ? inp(C, 1) : nullptr, (const f32x2*)(ws_ + WS_RS2), L == 0 ? nullptr : inp(C, 20), L == 0 ? nullptr : inp(C, 21), (bf16_t*)(ws_ + WS_H32), (float*)(ws_ + WS_STAT)};
    pg8::gemm_phase<EpiRes<L == 0 ? 0 : 1>, QueueOrder, true, true>(C.lds, g, S, E);
    conv_queue(C, L == 0 ? 2 : 6, L == 0 ? CV_S2 : CV_S5, L == 0 ? CV_S3 : CV_END);
}
template <int L> PHASE_FN ph_ln1() { const Ctx C = make_ctx(); unsigned char* const ws_ = wsp(C); p_ln_apply(C, inp(C, 18) + (size_t)L * D, inp(C, 19) + (size_t)L * D, (bf16_t*)(ws_ + WS_XB), nullptr); }
template <int L> PHASE_FN ph_gemm_up() {
    const Ctx C = make_ctx(); unsigned char* const ws_ = wsp(C); float* const out_ = outp(C);
    pg8::Gemm g{(const bf16_t*)(ws_ + WS_XB), (const bf16_t*)(ws_ + (L == 0 ? WS_W_UP0 : WS_W_UP1)), M, NUP, D}; const QueueOrder S = make_queue(C, ws_, 4 + L, M, NUP);
    EpiUpConv E{(bf16_t*)(ws_ + WS_HG), (bf16_t*)(ws_ + WS_SIDE), out_ + OUT_CP + (size_t)L * 4 * 2 * DFF, out_ + OUT_CS + (size_t)L * 32 * 2 * DFF, inp(C, 15) + (size_t)L * 3 * DFF, inp(C, 16) + (size_t)L * DFF};
    pg8::gemm_phase<EpiUpConv, QueueOrder, true, true>(C.lds, g, S, E);
    if (L == 0) conv_queue(C, 3, CV_S3, CV_S4);
}
template <int L> PHASE_FN ph_conv() { const Ctx C = make_ctx(); p_convfix(C, L); }
template <int L> PHASE_FN ph_gemm_dn() {
    const Ctx C = make_ctx(); unsigned char* const ws_ = wsp(C);
    pg8::Gemm g{(const bf16_t*)(ws_ + WS_HG), (const bf16_t*)(ws_ + (L == 0 ? WS_W_DN0 : WS_W_DN1)), M, D, DFF}; QueueOrder S = make_queue(C, ws_, 6 + L, M, D);
    EpiRes<1> E{nullptr, nullptr, (const f32x2*)(ws_ + WS_RS2), inp(C, 18) + (size_t)L * D, inp(C, 19) + (size_t)L * D, (bf16_t*)(ws_ + WS_H32), (float*)(ws_ + WS_STAT)};
    if (L == 1 && C.G == 256) {
        S.b.cap = 4 * 256;
        pg8::gemm_phase<EpiRes<1>, QueueOrder, true, true>(C.lds, g, S, E);
        const int kq = C.bid & 3, kt0 = kq == 0 ? 0 : (kq == 1 ? 44 : (kq == 2 ? 88 : 130)), nkt = kq < 2 ? 44 : 42;
        pg8::Gemm g2{g.A + kt0 * 64, g.Bt + kt0 * 64, M, D, nkt * 64, DFF};
        SplitOrder S2; S2.b.init(M, D, C.G, 0); S2.L = 4 * 256 + (C.bid >> 2);
        EpiPartial E2{(float*)(ws_ + WS_SLAB) + (size_t)C.bid * 65536};
        pg8::gemm_phase<EpiPartial, SplitOrder, true, true>(C.lds, g2, S2, E2);
    } else {
        pg8::gemm_phase<EpiRes<1>, QueueOrder, true, true>(C.lds, g, S, E);
        if (L == 0) conv_queue(C, 4, CV_S4, CV_S4B);
    }
}
PHASE_FN ph_dnfix() {
    const Ctx C = make_ctx(); unsigned char* const ws_ = wsp(C);
    if (C.G != 256) return;
    EpiRes<1> E{nullptr, nullptr, (const f32x2*)(ws_ + WS_RS2), inp(C, 18) + (size_t)D, inp(C, 19) + (size_t)D, (bf16_t*)(ws_ + WS_H32), (float*)(ws_ + WS_STAT)};
    pg8::StaticOrder S; S.init(M, D, C.G, 0);
    const int wr = C.wave >> 2, wc = C.wave & 3, fr = C.lane & 15, fq = C.lane >> 4;
    const unsigned t = (unsigned)(((wr * 4 + wc) * 4 + fq) * 16 + fr);
    for (int idx = C.bid >> 2; idx < 64; idx += 64) {
        pg8::Unit u; if (!S.unit_of(4 * 256 + idx, u)) break;
        const float* slab = (const float*)(ws_ + WS_SLAB) + (size_t)idx * 4 * 65536;
        pg8::f32x4 acc[2][2][4][2];
#define DNFIX_PART(AI, MH) do { \
            _Pragma("unroll") for (int bj = 0; bj < 2; ++bj) _Pragma("unroll") for (int m = 2 * (MH); m < 2 * (MH) + 2; ++m) { \
                  \
                const unsigned o0 = ((unsigned)(((((AI) * 2 + bj) * 4 + m) * 2 + 0) * 512) + t) * 16u, o1 = o0 + 512u * 16u; \
                const pg8::f32x4 a0 = ldo<pg8::f32x4>(slab, o0), a1 = ldo<pg8::f32x4>(slab + 65536, o0), a2 = ldo<pg8::f32x4>(slab + 2 * 65536, o0), a3 = ldo<pg8::f32x4>(slab + 3 * 65536, o0); \
                const pg8::f32x4 b0 = ldo<pg8::f32x4>(slab, o1), b1 = ldo<pg8::f32x4>(slab + 65536, o1), b2 = ldo<pg8::f32x4>(slab + 2 * 65536, o1), b3 = ldo<pg8::f32x4>(slab + 3 * 65536, o1); \
                acc[AI][bj][m][0] = (a0 + a1) + (a2 + a3); acc[AI][bj][m][1] = (b0 + b1) + (b2 + b3); } \
            E.run<AI, AI + 1, 2 * (MH), 2 * (MH) + 2>(acc, u, wr, wc, fr, fq); } while (0)
        switch (C.bid & 3) { case 0: DNFIX_PART(0, 0); break; case 1: DNFIX_PART(0, 1); break; case 2: DNFIX_PART(1, 0); break; default: DNFIX_PART(1, 1); break; }
#undef DNFIX_PART
    }
}
template <int L> PHASE_FN ph_ln2() {
    const Ctx C = make_ctx(); unsigned char* const ws_ = wsp(C);
    p_ln_apply(C, inp(C, 20) + (size_t)L * D, inp(C, 21) + (size_t)L * D, L == 0 ? (bf16_t*)(ws_ + WS_XB) : nullptr, L == 0 ? nullptr : outp(C) + OUT_Y);
}
PHASE_FN ph_barrier() {
    const Ctx C = make_ctx();
    XcdBarrier b; b.bar = (unsigned*)(wsp(C) + WS_CTL) + CW_BAR; b.x = xb_xcc_id(); b.st = (volatile LAS unsigned*)(C.lds + MISC_OFF) + 8;
    xcd_barrier(b);
}

struct Args { const float* in[22]; float* out; unsigned char* ws; int ph_lo, ph_hi; };
static_assert(sizeof(Args) == 22 * 8 + 8 + 8 + 8, "Args has no padding");

__global__ void __launch_bounds__(512, 2) fwd_kernel(Args args) {
    LAS unsigned char* lds = (LAS unsigned char*)lds_raw;
    const int tid = threadIdx.x;
    volatile LAS unsigned* MISC = (volatile LAS unsigned*)(lds + MISC_OFF);
    if (tid < 64) MISC[tid] = 0u;
    if (tid == 64) {
        volatile LAS unsigned long long* pt = (volatile LAS unsigned long long*)(lds + PTR_OFF);
#pragma unroll
        for (int i = 0; i < 22; ++i) pt[i] = (unsigned long long)args.in[i];
        pt[22] = (unsigned long long)args.out; pt[23] = (unsigned long long)args.ws;
    }
    __syncthreads();
    if (N_LAUNCHES == 1) (void)xcd_barrier_post((unsigned*)(args.ws + WS_CTL) + CW_BAR, MISC + 8);
#ifndef REPS
#define REPS {1,1,1,1,1,1,1,1,1,1,1,1,1,1,1,1,1,1,1,1}
#endif
    constexpr int REPS_[NPHASE] = REPS;
    const int lo = args.ph_lo, hi = args.ph_hi;
#define IN(k) (lo <= (k) && (k) < hi)
#define SEAM(k) do { if (IN(k) && IN((k) + 1)) ph_barrier(); } while (0)
    if (IN(0)) { for (int r_ = 0; r_ < REPS_[0]; ++r_) ph_prologue(); }
    SEAM(0);
    if (IN(1)) { for (int r_ = 0; r_ < REPS_[1]; ++r_) ph_gemm_ain(); }

    SEAM(1);
    if (IN(2)) { for (int r_ = 0; r_ < REPS_[2]; ++r_) ph_rowstat(); }
    SEAM(2);
    if (IN(3)) { for (int r_ = 0; r_ < REPS_[3]; ++r_) ph_spatial(); }
    SEAM(3);
    if (IN(4)) { for (int r_ = 0; r_ < REPS_[4]; ++r_) ph_gemm_out<0>(); }
    SEAM(4);
    if (IN(5)) { for (int r_ = 0; r_ < REPS_[5]; ++r_) ph_ln1<0>(); }
    SEAM(5);
    if (IN(6)) { for (int r_ = 0; r_ < REPS_[6]; ++r_) ph_gemm_up<0>(); }
#ifdef PROBE_NULL
    if (IN(6)) { ph_barrier(); ph_probe(); }
#endif
    SEAM(6);
    if (IN(7)) { for (int r_ = 0; r_ < REPS_[7]; ++r_) ph_conv<0>(); }
    SEAM(7);
    if (IN(8)) { for (int r_ = 0; r_ < REPS_[8]; ++r_) ph_gemm_dn<0>(); }
    SEAM(8);
    if (IN(9)) { for (int r_ = 0; r_ < REPS_[9]; ++r_) ph_ln2<0>(); }
    SEAM(9);
    if (IN(10)) { for (int r_ = 0; r_ < REPS_[10]; ++r_) ph_gemm_bin(); }
    SEAM(10);
    if (IN(12)) { for (int r_ = 0; r_ < REPS_[12]; ++r_) ph_gla(); }
    SEAM(12);
    if (IN(13)) { for (int r_ = 0; r_ < REPS_[13]; ++r_) ph_gemm_out<1>(); }
    SEAM(13);
    if (IN(14)) { for (int r_ = 0; r_ < REPS_[14]; ++r_) ph_ln1<1>(); }
    SEAM(14);
    if (IN(15)) { for (int r_ = 0; r_ < REPS_[15]; ++r_) ph_gemm_up<1>(); }
    SEAM(15);
    if (IN(16)) { for (int r_ = 0; r_ < REPS_[16]; ++r_) ph_conv<1>(); }
    SEAM(16);
    if (IN(17)) { for (int r_ = 0; r_ < REPS_[17]; ++r_) ph_gemm_dn<1>(); }
    SEAM(17);
    if (IN(18)) { for (int r_ = 0; r_ < REPS_[18]; ++r_) ph_dnfix(); }
    SEAM(18);
    if (IN(19)) { for (int r_ = 0; r_ < REPS_[19]; ++r_) ph_ln2<1>(); }
#undef IN
#undef SEAM
}

#ifdef DBG_STOP
__global__ void dbg_fold(const unsigned* src, size_t n_words, float* out, size_t n_out) {
    for (size_t j = (size_t)blockIdx.x * blockDim.x + threadIdx.x; j < n_out; j += (size_t)gridDim.x * blockDim.x) {
        unsigned acc = 0u; for (size_t i = j; i < n_words; i += n_out) acc ^= src[i];
        acc ^= acc >> 16; acc ^= acc >> 8; out[j] = (float)(acc & 0xffu);
    }
}
#endif
extern "C" void kernel_launch(void* const* d_in, const int* in_sizes, int n_in, void* d_out, int out_size, void* d_ws, size_t ws_size, hipStream_t stream) {
    static int grid = 0;
    if (grid == 0) {
        if (n_in != 22 || (size_t)out_size != OUT_END || ws_size < WS_END) { fprintf(stderr, "kernel_launch: unexpected shapes (n_in %d, out %d, ws %zu)\n", n_in, out_size, ws_size); grid = -1; return; }
        int dev = 0, cus = 0;
        if (hipGetDevice(&dev) != hipSuccess || hipDeviceGetAttribute(&cus, hipDeviceAttributeMultiprocessorCount, dev) != hipSuccess) { grid = -1; return; }
        if (hipFuncSetAttribute((const void*)fwd_kernel, hipFuncAttributeMaxDynamicSharedMemorySize, LDS_BYTES) != hipSuccess) { fprintf(stderr, "kernel_launch: hipFuncSetAttribute failed\n"); grid = -1; return; }
        int per_cu = 0;
        if (hipOccupancyMaxActiveBlocksPerMultiprocessor(&per_cu, (const void*)fwd_kernel, 512, LDS_BYTES) != hipSuccess || per_cu < 1) fprintf(stderr, "kernel_launch: occupancy query says %d\n", per_cu);
        (void)hipGetLastError();
        grid = cus;
    }
    if (grid < 0) return;
    (void)hipMemsetAsync((char*)d_ws + WS_CTL, 0, CTL_BYTES, stream);
    Args a{};
    for (int i = 0; i < 22; ++i) a.in[i] = (const float*)d_in[i];
    a.out = (float*)d_out; a.ws = (unsigned char*)d_ws;
    if (N_LAUNCHES == 1) { a.ph_lo = 0; a.ph_hi = NPHASE; hipLaunchKernelGGL(fwd_kernel, dim3(grid), dim3(512), LDS_BYTES, stream, a); }
    else for (int p = 0; p < NPHASE; ++p) {
#ifdef DBG_STOP
        if (p > DBG_STOP) break;
#endif
        a.ph_lo = p; a.ph_hi = p + 1; hipLaunchKernelGGL(fwd_kernel, dim3(grid), dim3(512), LDS_BYTES, stream, a); }
#ifdef DBG_STOP
    hipLaunchKernelGGL(dbg_fold, dim3(2048), dim3(256), 0, stream, (const unsigned*)((const char*)d_ws + (size_t)(DBG_OFF)), (size_t)(DBG_BYTES) / 4, (float*)d_out, (size_t)out_size);
#endif
}
```

```cpp
#include <hip/hip_runtime.h>
#include <cstdio>
#include <cstdint>
#define LAS __attribute__((address_space(3)))
#define GAS __attribute__((address_space(1)))
#define N_LAUNCHES 1

namespace pg8 {
#define PG8_LAS __attribute__((address_space(3)))
typedef unsigned short bf16_t;
typedef short bf16x8 __attribute__((ext_vector_type(8)));
typedef float f32x4 __attribute__((ext_vector_type(4)));
typedef unsigned u32x4 __attribute__((ext_vector_type(4)));
constexpr int BM = 256, BK = 64, HALF = 128, HTB = HALF * BK * 2  , STAGE_BYTES = 8 * HTB, NXCD = 8, WGM = 8;

__host__ __device__ __forceinline__ int lds_byte(int r, int c) { const int st = (r >> 4) * 2 + (c >> 5), rr = r & 15, cc = c & 31, ob = rr * 64 + cc * 2; return st * 1024 + (ob ^ (((ob >> 9) & 1) << 5)); }
__host__ __device__ __forceinline__ void stage_rc(int b, int& R, int& C) { const int st = b / 1024, sb = b % 1024, swz = sb ^ (((sb >> 9) & 1) << 5); R = (st >> 1) * 16 + swz / 64; C = (st & 1) * 32 + (swz % 64) / 2; }
__host__ __device__ __forceinline__ int perm32(int rho) { const int n = rho >> 4, i = rho & 15; return 8 * (i >> 2) + 4 * n + (i & 3); }

struct Unit { int pm, pn; };
struct Gemm { const bf16_t* A; const bf16_t* Bt; int M, N, K, P; };

struct StaticOrder {
    int nM, nN, nwg, G, c, cap;
    __host__ __device__ void init(int M, int N, int G_, int c_) { nM = M / BM; nN = N / BM; nwg = nM * nN; G = G_; c = c_; cap = nwg; }
    __host__ __device__ bool next(int i, Unit& u) const { return unit_of((long)i * G + c, u); }
    __host__ __device__ bool unit_of(long L, Unit& u) const {
        if (L >= cap) return false;
        int wgid = (int)L;
        { const int nig0 = WGM * nN, rem = nwg - NXCD * nig0;
          if (nM / WGM == NXCD && rem >= 0 && rem % NXCD == 0) {
              const int x = wgid % NXCD, t = wgid / NXCD, rem8 = rem / NXCD;
              wgid = t < nig0 ? x * nig0 + t : NXCD * nig0 + x * rem8 + (t - nig0);
          } else { const int q = nwg / NXCD, r = nwg % NXCD, xcd = wgid % NXCD, off = wgid / NXCD; wgid = (xcd < r ? xcd * (q + 1) : r * (q + 1) + (xcd - r) * q) + off; } }
        const int nig = WGM * nN, gid = wgid / nig, fm = gid * WGM, gsz = (nM - fm) < WGM ? (nM - fm) : WGM;
        u.pm = fm + ((wgid % nig) % gsz); u.pn = (wgid % nig) / gsz; return true;
    }
    __device__ __forceinline__ void a_ready(const Unit&) const {}
    __device__ __forceinline__ void done(const Unit&) const {}
    __device__ __forceinline__ int issue(int, int, int) const { return 0; }
    __device__ __forceinline__ bool resolve(int, int i, Unit& u, int, int) const { return next(i, u); }
};

__device__ __forceinline__ unsigned cvt_pk_bf16(float lo, float hi) { unsigned r; asm volatile("v_cvt_pk_bf16_f32 %0, %1, %2" : "=v"(r) : "v"(lo), "v"(hi)); return r; }
template <class Epi, class Sched, bool ALIGN_EPI = false, bool SP2 = false>
__device__ __forceinline__ void gemm_phase(PG8_LAS unsigned char* lds, const Gemm g, const Sched& S, const Epi& E) {
    int tid_ = threadIdx.x; asm volatile("" : "+v"(tid_));
    const int tid = tid_, wid = __builtin_amdgcn_readfirstlane(tid >> 6), lane = tid & 63, wr = wid >> 2, wc = wid & 3, fr = lane & 15, fq = lane >> 4;
    const int nt = g.K / BK, K = g.P ? g.P : g.K;
    unsigned voffA[2], voffB[2];
#pragma unroll
    for (int i = 0; i < 2; ++i) { int R, C; stage_rc(tid * 16 + i * 8192, R, C); const int Rb = Epi::PERM ? ((R & ~31) + perm32(R & 31)) : R;
        voffA[i] = (unsigned)(R * K + C) * 2u; voffB[i] = (unsigned)(Rb * K + C) * 2u; }
    const size_t kstep = (size_t)(BK * 2);
    const size_t hstep = (size_t)HALF * K * 2;
    const size_t tstep = 2 * hstep;
    const unsigned ldsw = (unsigned)wid * 1024u;
    const int aoff = lds_byte(wr * 64 + fr, fq * 8), boff = lds_byte(wc * 32 + fr, fq * 8);
#define PG8_SA(b, h) (((b) * 2 + (h)) * HTB)
#define PG8_SB(b, h) ((4 + (b) * 2 + (h)) * HTB)
#define PG8_STAGE(bufoff, gbase, voff) do { _Pragma("unroll") for (int _i = 0; _i < 2; ++_i) \
        __builtin_amdgcn_global_load_lds((const unsigned*)((const char*)(gbase) + (voff)[_i]), (PG8_LAS unsigned*)(lds + (bufoff) + ldsw + _i * 8192), 16, 0, 0); } while (0)
#define PG8_LDA(dst, b, h) do { _Pragma("unroll") for (int m = 0; m < 4; ++m) _Pragma("unroll") for (int k = 0; k < 2; ++k) dst[m][k] = *(const PG8_LAS bf16x8*)(lds + PG8_SA(b, h) + aoff + m * 2048 + k * 1024); } while (0)
#define PG8_LDB(dst, b, h) do { _Pragma("unroll") for (int n = 0; n < 2; ++n) _Pragma("unroll") for (int k = 0; k < 2; ++k) dst[n][k] = *(const PG8_LAS bf16x8*)(lds + PG8_SB(b, h) + boff + n * 2048 + k * 1024); } while (0)
#define PG8_MMA(ai, bj, At, Bt) do { __builtin_amdgcn_s_setprio(1); _Pragma("unroll") for (int m = 0; m < 4; ++m) _Pragma("unroll") for (int n = 0; n < 2; ++n) _Pragma("unroll") for (int k = 0; k < 2; ++k) \
        acc[ai][bj][m][n] = __builtin_amdgcn_mfma_f32_16x16x32_bf16(Bt[n][k], At[m][k], acc[ai][bj][m][n], 0, 0, 0); __builtin_amdgcn_s_setprio(0); } while (0)
#define PG8_WAIT_V(n) asm volatile("s_waitcnt vmcnt(" #n ")" ::: "memory")
#define PG8_WAIT_L(n) asm volatile("s_waitcnt lgkmcnt(" #n ")" ::: "memory")
#define PG8_BAR __builtin_amdgcn_s_barrier()
#define PG8_SCHED __builtin_amdgcn_sched_barrier(0)
    Unit cur, nxt; int ui = 0;
    { const int tk0 = S.issue(0, wid, lane); if (!S.resolve(tk0, 0, cur, wid, lane)) return; }
    f32x4 acc[2][2][4][2];
#pragma unroll
    for (int a = 0; a < 2; ++a)
#pragma unroll
        for (int b = 0; b < 2; ++b)
#pragma unroll
            for (int m = 0; m < 4; ++m)
#pragma unroll
                for (int n = 0; n < 2; ++n) acc[a][b][m][n] = (f32x4){0.f, 0.f, 0.f, 0.f};
    bf16x8 At[4][2], B0[2][2], B1[2][2];
    const char* cA = (const char*)g.A + (size_t)cur.pm * tstep; const char* cB = (const char*)g.Bt + (size_t)cur.pn * tstep;
    S.a_ready(cur);
    if constexpr (SP2) {
        PG8_STAGE(PG8_SB(0, 0), cB, voffB); PG8_STAGE(PG8_SB(0, 1), cB + hstep, voffB); PG8_STAGE(PG8_SA(0, 0), cA, voffA); PG8_STAGE(PG8_SA(0, 1), cA + hstep, voffA);
        if (wr == 1) PG8_BAR;
        PG8_WAIT_V(2); PG8_BAR;
        PG8_STAGE(PG8_SB(1, 0), cB + kstep, voffB); PG8_STAGE(PG8_SA(1, 0), cA + kstep, voffA); PG8_STAGE(PG8_SB(1, 1), cB + hstep + kstep, voffB);
        PG8_WAIT_V(6); PG8_BAR;
    } else {
        PG8_STAGE(PG8_SB(0, 0), cB, voffB); PG8_STAGE(PG8_SA(0, 0), cA, voffA); PG8_STAGE(PG8_SB(0, 1), cB + hstep, voffB); PG8_STAGE(PG8_SA(0, 1), cA + hstep, voffA);
        if (wr == 1) PG8_BAR;
        PG8_WAIT_V(4); PG8_BAR;
        PG8_STAGE(PG8_SB(1, 0), cB + kstep, voffB); PG8_STAGE(PG8_SA(1, 0), cA + kstep, voffA); PG8_STAGE(PG8_SB(1, 1), cB + hstep + kstep, voffB);
        PG8_WAIT_V(6); PG8_BAR;
    }
    for (;;) {
        const int tk = S.issue(ui + 1, wid, lane);
        bool has_next = false;
        const char* nA = cA; const char* nB = cB;
        for (int t = 0; t < nt; t += 2) {
            const bool last = (t == nt - 2);
            if (last) { has_next = S.resolve(tk, ui + 1, nxt, wid, lane); if (has_next) { nA = (const char*)g.A + (size_t)nxt.pm * tstep; nB = (const char*)g.Bt + (size_t)nxt.pn * tstep; } }
            const char* a1 = cA + (size_t)(t + 1) * kstep;
            const char* a2 = last ? nA : cA + (size_t)(t + 2) * kstep; const char* b2 = last ? nB : cB + (size_t)(t + 2) * kstep;
            const char* a3 = a2 + kstep; const char* b3 = b2 + kstep;
            if (last && has_next) S.a_ready(nxt);
            if constexpr (SP2) {
            PG8_LDB(B0, 0, 0); PG8_LDB(B1, 0, 1); PG8_SCHED; PG8_LDA(At, 0, 0); PG8_STAGE(PG8_SA(1, 1), a1 + hstep, voffA);
            PG8_WAIT_V(8); PG8_WAIT_L(0); PG8_BAR; PG8_MMA(0, 0, At, B0); PG8_MMA(0, 1, At, B1); PG8_BAR; PG8_SCHED;
            PG8_LDA(At, 0, 1); PG8_STAGE(PG8_SB(0, 0), b2, voffB); PG8_STAGE(PG8_SB(0, 1), b2 + hstep, voffB); PG8_STAGE(PG8_SA(0, 0), a2, voffA);
            PG8_WAIT_V(8); PG8_WAIT_L(0); PG8_BAR; PG8_MMA(1, 0, At, B0); PG8_MMA(1, 1, At, B1); PG8_BAR; PG8_SCHED;
            PG8_LDB(B0, 1, 0); PG8_LDB(B1, 1, 1); PG8_SCHED; PG8_LDA(At, 1, 0); PG8_STAGE(PG8_SA(0, 1), a2 + hstep, voffA);
            PG8_WAIT_V(8); PG8_WAIT_L(0); PG8_BAR; PG8_MMA(0, 0, At, B0); PG8_MMA(0, 1, At, B1); PG8_BAR; PG8_SCHED;
            PG8_LDA(At, 1, 1); PG8_STAGE(PG8_SB(1, 0), b3, voffB); PG8_STAGE(PG8_SB(1, 1), b3 + hstep, voffB); PG8_STAGE(PG8_SA(1, 0), a3, voffA);
            PG8_WAIT_V(8); PG8_WAIT_L(0); PG8_BAR; PG8_MMA(1, 0, At, B0); PG8_MMA(1, 1, At, B1); PG8_BAR; PG8_SCHED;
            } else {
            PG8_LDB(B0, 0, 0); PG8_SCHED; PG8_LDA(At, 0, 0); PG8_STAGE(PG8_SA(1, 1), a1 + hstep, voffA);
            PG8_WAIT_L(8); PG8_BAR; PG8_WAIT_L(0); PG8_MMA(0, 0, At, B0); PG8_BAR; PG8_SCHED;
            PG8_LDB(B1, 0, 1); PG8_STAGE(PG8_SB(0, 0), b2, voffB);
            PG8_BAR; PG8_WAIT_L(0); PG8_MMA(0, 1, At, B1); PG8_BAR;
            PG8_LDA(At, 0, 1); PG8_STAGE(PG8_SA(0, 0), a2, voffA);
            PG8_BAR; PG8_WAIT_L(0); PG8_MMA(1, 0, At, B0); PG8_BAR; PG8_SCHED;
            PG8_STAGE(PG8_SB(0, 1), b2 + hstep, voffB);
            PG8_WAIT_V(6); PG8_BAR; PG8_MMA(1, 1, At, B1); PG8_BAR;
            PG8_LDB(B0, 1, 0); PG8_SCHED; PG8_LDA(At, 1, 0); PG8_STAGE(PG8_SA(0, 1), a2 + hstep, voffA);
            PG8_WAIT_L(8); PG8_BAR; PG8_WAIT_L(0); PG8_MMA(0, 0, At, B0); PG8_BAR; PG8_SCHED;
            PG8_LDB(B1, 1, 1); PG8_STAGE(PG8_SB(1, 0), b3, voffB);
            PG8_BAR; PG8_WAIT_L(0); PG8_MMA(0, 1, At, B1); PG8_BAR;
            PG8_LDA(At, 1, 1); PG8_STAGE(PG8_SA(1, 0), a3, voffA);
            PG8_BAR; PG8_WAIT_L(0); PG8_MMA(1, 0, At, B0); PG8_BAR; PG8_SCHED;
            PG8_STAGE(PG8_SB(1, 1), b3 + hstep, voffB);
            PG8_WAIT_V(6); PG8_BAR; PG8_MMA(1, 1, At, B1); PG8_BAR;
            }
        }
        if constexpr (ALIGN_EPI) { if (wr == 0) PG8_BAR; }
        if constexpr (!Epi::AFTER_DRAIN) { E(acc, cur, wr, wc, fr, fq); S.done(cur); }
        if (!has_next) break;
#pragma unroll
        for (int a = 0; a < 2; ++a)
#pragma unroll
            for (int b = 0; b < 2; ++b)
#pragma unroll
                for (int m = 0; m < 4; ++m)
#pragma unroll
                    for (int n = 0; n < 2; ++n) acc[a][b][m][n] = (f32x4){0.f, 0.f, 0.f, 0.f};
        cur = nxt; cA = nA; cB = nB; ++ui;
        if constexpr (ALIGN_EPI) { if (wr == 1) PG8_BAR; }
    }
    PG8_WAIT_V(0);
    if constexpr (!ALIGN_EPI) { if (wr == 0) PG8_BAR; }
    PG8_BAR;
    if constexpr (Epi::AFTER_DRAIN) { E.fused(acc, cur, wr, wc, fr, fq, lds, wid, lane); S.done(cur); }
#undef PG8_SA
#undef PG8_SB
#undef PG8_STAGE
#undef PG8_LDA
#undef PG8_LDB
#undef PG8_MMA
#undef PG8_WAIT_V
#undef PG8_WAIT_L
#undef PG8_BAR
#undef PG8_SCHED
}
}
#define XB_TMO      128
#define XB_XCNT(j)  (256  + 64 * (j))
#define XB_XSUB(j)  (1280 + 64 * (j))
#define XB_XGEN(j)  (2304 + 64 * (j))
#define XB_TOP      3328
#define XB_TOPGEN   3392
#define XCD_BAR_WORDS 3456
#define XB_SPIN_CAP (1u << 18)

__device__ __forceinline__ unsigned xb_ld(unsigned* p)              { return __hip_atomic_load(p, __ATOMIC_RELAXED, __HIP_MEMORY_SCOPE_AGENT); }
__device__ __forceinline__ unsigned xb_add(unsigned* p, unsigned v) { return __hip_atomic_fetch_add(p, v, __ATOMIC_RELAXED, __HIP_MEMORY_SCOPE_AGENT); }
__device__ __forceinline__ unsigned xb_xcc_id() { return (unsigned)__builtin_amdgcn_s_getreg((3 << 11) | 20) & 0xFu; }
#define XB_SPIN(cond, bar) do { unsigned _sp = 0; while (cond) { __builtin_amdgcn_s_sleep(1); \
    if ((++_sp & 255u) == 0u) { if (xb_ld(&(bar)[XB_TMO])) break; if (_sp > XB_SPIN_CAP) { atomicAdd(&(bar)[XB_TMO], 1u); break; } } } } while (0)

struct XcdBarrier {
    unsigned* bar; unsigned x;
    volatile LAS unsigned* st;
};

__device__ __forceinline__ XcdBarrier xcd_barrier_post(unsigned* bar, volatile LAS unsigned* st) {
    XcdBarrier b; b.bar = bar; b.x = xb_xcc_id(); b.st = st;
    if (threadIdx.x == 0) (void)xb_add(&bar[XB_XCNT(b.x)], 1u);
    return b;
}
__device__ __forceinline__ void xcd_barrier_complete(unsigned* bar, unsigned x, unsigned& nloc, unsigned& nx) {
    const unsigned G = gridDim.x * gridDim.y * gridDim.z;
    unsigned sum, cnt, mine, sp = 0u;
    for (;;) {
        sum = 0u; cnt = 0u; mine = 0u;
#pragma unroll
        for (unsigned j = 0; j < 16; ++j) { const unsigned c = xb_ld(&bar[XB_XCNT(j)]); sum += c; cnt += (c > 0u) ? 1u : 0u; mine = (j == x) ? c : mine; }
        if (sum == G) break;
        __builtin_amdgcn_s_sleep(1);
        if ((++sp & 255u) == 0u) { if (xb_ld(&bar[XB_TMO])) break; if (sp > XB_SPIN_CAP) { atomicAdd(&bar[XB_TMO], 1u); break; } }
    }
    nloc = mine > 0u ? mine : 1u; nx = cnt > 0u ? cnt : 1u;
}

__device__ __forceinline__ void xcd_barrier(const XcdBarrier& b) {
    asm volatile("s_waitcnt vmcnt(0)" ::: "memory");
    __syncthreads();
    if (threadIdx.x == 0) {
        unsigned* bar = b.bar;
        __builtin_amdgcn_s_waitcnt(0);
        unsigned nloc = b.st[0], nx = b.st[1];
        if (nloc == 0u) { xcd_barrier_complete(bar, b.x, nloc, nx); b.st[0] = nloc; b.st[1] = nx; }
        const unsigned old = xb_add(&bar[XB_XSUB(b.x)], 1u);
        const unsigned gen = old / nloc;
        if (old + 1u == (gen + 1u) * nloc) {
            __builtin_amdgcn_fence(__ATOMIC_RELEASE, "agent");
            asm volatile("s_waitcnt vmcnt(0)" ::: "memory");
            const unsigned og = xb_add(&bar[XB_TOP], 1u);
            const unsigned tg = og / nx;
            if (og + 1u == (tg + 1u) * nx) xb_add(&bar[XB_TOPGEN], 1u);
            else XB_SPIN(xb_ld(&bar[XB_TOPGEN]) == tg, bar);
            __builtin_amdgcn_fence(__ATOMIC_ACQUIRE, "agent");
            xb_add(&bar[XB_XGEN(b.x)], 1u);
            asm volatile("s_waitcnt vmcnt(0)" ::: "memory");
        } else {
            XB_SPIN(xb_ld(&bar[XB_XGEN(b.x)]) == gen, bar);
            __builtin_amdgcn_fence(__ATOMIC_ACQUIRE, "agent");
            asm volatile("s_waitcnt vmcnt(0)" ::: "memory");
        }
    }
    __syncthreads();
}
#ifndef N_LAUNCHES
#define N_LAUNCHES 1
#endif
constexpr int MP = 16384, MS = 1024, M = MP + MS, D = 4096, DFF = 11008, NUP = 2 * DFF, NAIN = 8192, NBIN = 16384;
constexpr int NPHASE = 20;
constexpr float ALPHA = 1.41421356237309515f, LN_EPS = 1e-5f, RMS_EPS = 1e-6f;
typedef unsigned short bf16_t;
typedef float f32x4 __attribute__((ext_vector_type(4)));
typedef float f32x2 __attribute__((ext_vector_type(2)));
typedef unsigned u32x4 __attribute__((ext_vector_type(4)));
typedef unsigned u32x2 __attribute__((ext_vector_type(2)));
typedef short bf16x8 __attribute__((ext_vector_type(8)));
typedef short s16x4 __attribute__((ext_vector_type(4)));

constexpr size_t MiB = 1u << 20;
constexpr size_t WS_CTL = 0, CTL_BYTES = 1 * MiB;
constexpr size_t WS_W_AIN = 1 * MiB;
constexpr size_t WS_W_AOUT = WS_W_AIN + 64 * MiB;
constexpr size_t WS_W_UP0 = WS_W_AOUT + 32 * MiB;
constexpr size_t WS_W_DN0 = WS_W_UP0 + 172 * MiB;
constexpr size_t WS_W_BIN = WS_W_DN0 + 86 * MiB;
constexpr size_t WS_W_BOUT = WS_W_BIN + 128 * MiB;
constexpr size_t WS_W_UP1 = WS_W_BOUT + 32 * MiB;
constexpr size_t WS_W_DN1 = WS_W_UP1 + 172 * MiB;
constexpr size_t WS_XB = WS_W_DN1 + 86 * MiB;
constexpr size_t WS_X32 = WS_XB + 136 * MiB;
constexpr size_t WS_H32 = WS_X32 + 272 * MiB;
constexpr size_t WS_STAT = WS_H32 + 272 * MiB;
constexpr size_t WS_ROWSTAT = WS_STAT + 9 * MiB;
constexpr size_t WS_LB = WS_ROWSTAT + 512 * 1024;
constexpr size_t WS_RS2 = WS_ROWSTAT + 768 * 1024;
constexpr size_t WS_BIG = WS_ROWSTAT + 1 * MiB;
constexpr size_t WS_Z = WS_BIG;
constexpr size_t WS_GATED = WS_BIG + 272 * MiB;
constexpr size_t WS_SIDE = WS_BIG;
constexpr size_t WS_HG = WS_BIG + 731 * MiB;
constexpr size_t WS_Q = WS_BIG;
constexpr size_t WS_ZF = WS_BIG + 136 * MiB;
constexpr size_t WS_V = WS_BIG + 272 * MiB;
constexpr size_t WS_G = WS_BIG + 408 * MiB;
constexpr size_t WS_O = WS_BIG + 816 * MiB;
constexpr size_t WS_DCH = WS_BIG + 952 * MiB;
constexpr size_t WS_QS = WS_X32;
constexpr size_t WS_KD = WS_X32 + 136 * MiB;
constexpr size_t WS_SLAB = WS_BIG + 128 * MiB;
constexpr size_t WS_END = WS_BIG + 1097 * MiB;
static_assert(WS_HG + (size_t)M * DFF * 2 <= WS_END && WS_DCH + (size_t)(M / 32) * D * 4 <= WS_END, "ws map");
constexpr size_t OUT_Y = 0, OUT_NV = (size_t)M * D, OUT_SP = OUT_NV + (size_t)MS * D, OUT_SS = OUT_SP + (size_t)4 * 32 * 128 * 128,
                 OUT_CP = OUT_SS + (size_t)32 * 32 * 128 * 128, OUT_CS = OUT_CP + (size_t)2 * 4 * 2 * DFF, OUT_END = OUT_CS + (size_t)2 * 32 * 2 * DFF;
constexpr int LDS_BYTES = 163840, MISC_OFF = LDS_BYTES - 256, PTR_OFF = LDS_BYTES - 512;
constexpr int CW_BAR = 4096;

__device__ __forceinline__ float bf2f(unsigned b16) { return __uint_as_float(b16 << 16); }
typedef __bf16 bf16x2_t __attribute__((ext_vector_type(2)));
__device__ __forceinline__ unsigned pk2(float lo, float hi) { const f32x2 v = {lo, hi}; const bf16x2_t b = __builtin_convertvector(v, bf16x2_t); return __builtin_bit_cast(unsigned, b); }
__device__ __forceinline__ float bflo(unsigned w) { return __uint_as_float(w << 16); }
__device__ __forceinline__ float bfhi(unsigned w) { return __uint_as_float(w & 0xffff0000u); }
__device__ __forceinline__ float wave_sum(float v) {
#pragma unroll
    for (int o = 1; o < 64; o <<= 1) v += __shfl_xor(v, o);
    return v;
}
__device__ __forceinline__ float fexp(float x) { return __builtin_amdgcn_exp2f(x * 1.44269504088896341f); }
__device__ __forceinline__ float frcp(float x) { return __builtin_amdgcn_rcpf(x); }
__device__ __forceinline__ float fsigmoid(float x) { return frcp(1.0f + fexp(-x)); }
__device__ __forceinline__ float fsilu(float x) { return x * fsigmoid(x); }
__device__ __forceinline__ float fgelu_tanh(float x) {
    const float t = x * (1.5957691216057308f + 0.07135481627f * x * x);
    return x * frcp(1.0f + fexp(-t));
}
__device__ __forceinline__ s16x4 lds_tr(LAS unsigned char* p) { return __builtin_amdgcn_ds_read_tr16_b64_v4i16((LAS s16x4*)p); }
__device__ __forceinline__ bf16x8 cat4(s16x4 a, s16x4 b) { return (bf16x8){a[0], a[1], a[2], a[3], b[0], b[1], b[2], b[3]}; }
template <class T> __device__ __forceinline__ T ldo(const void* ubase, unsigned boff) { return *(const T*)((const char*)ubase + boff); }
template <class T> __device__ __forceinline__ void sto(void* ubase, unsigned boff, T v) { *(T*)((char*)ubase + boff) = v; }
#define LDS_WAIT() asm volatile("s_waitcnt lgkmcnt(0)" ::: "memory")
#define VM_WAIT() asm volatile("s_waitcnt vmcnt(0)" ::: "memory")

struct Ctx {
    LAS unsigned char* lds;
    int tid, lane, wave, G, bid;
};
extern __shared__ __attribute__((aligned(16))) unsigned char lds_raw[];
__device__ __forceinline__ Ctx make_ctx() {
    Ctx C; C.lds = (LAS unsigned char*)lds_raw; int t = threadIdx.x; asm volatile("" : "+v"(t));
    C.tid = t; C.lane = t & 63; C.wave = __builtin_amdgcn_readfirstlane(t >> 6); C.G = gridDim.x; C.bid = blockIdx.x; return C;
}
__device__ __forceinline__ unsigned long long ptab(const Ctx& C, int k) {
    const unsigned lo = *(volatile LAS unsigned*)(C.lds + PTR_OFF + 8 * k), hi = *(volatile LAS unsigned*)(C.lds + PTR_OFF + 8 * k + 4);
    return ((unsigned long long)(unsigned)__builtin_amdgcn_readfirstlane((int)hi) << 32) | (unsigned)__builtin_amdgcn_readfirstlane((int)lo);
}
__device__ __forceinline__ const float* inp(const Ctx& C, int k) { return (const float*)(GAS const float*)ptab(C, k); }
__device__ __forceinline__ float* outp(const Ctx& C) { return (float*)(GAS float*)ptab(C, 22); }
__device__ __forceinline__ unsigned char* wsp(const Ctx& C) { return (unsigned char*)(GAS unsigned char*)ptab(C, 23); }
__device__ __forceinline__ const float* xin_row(const float* xp, const float* xs, int row) { return row < MP ? xp + (size_t)row * D : xs + (size_t)(row - MP) * D; }

struct EpiGelu {
    static constexpr bool PERM = true, AFTER_DRAIN = false;
    bf16_t* Z; float* stat;
    __device__ __forceinline__ void operator()(const pg8::f32x4 (&acc)[2][2][4][2], const pg8::Unit& u, int wr, int wc, int fr, int fq) const {
        const int row0 = u.pm * 256 + wr * 64 + fr, col0 = u.pn * 256 + wc * 32 + 8 * fq;
        const bool isv = u.pn >= 16;
#pragma unroll
        for (int ai = 0; ai < 2; ++ai)
#pragma unroll
            for (int m = 0; m < 4; ++m) {
                const int row = row0 + ai * 128 + m * 16; float s1 = 0.f, s2 = 0.f;
#pragma unroll
                for (int bj = 0; bj < 2; ++bj) {
                    float z[8];
#pragma unroll
                    for (int j = 0; j < 4; ++j) { z[j] = fgelu_tanh(acc[ai][bj][m][0][j]); z[4 + j] = fgelu_tanh(acc[ai][bj][m][1][j]); }
#pragma unroll
                    for (int j = 0; j < 8; ++j) { s1 += z[j]; s2 += z[j] * z[j]; }
                    u32x4 w; w.x = pk2(z[0], z[1]); w.y = pk2(z[2], z[3]); w.z = pk2(z[4], z[5]); w.w = pk2(z[6], z[7]);
                    *(u32x4*)(Z + (size_t)row * NAIN + col0 + bj * 128) = w;
                }
                if (isv) {
                    s1 += __shfl_xor(s1, 16); s1 += __shfl_xor(s1, 32); s2 += __shfl_xor(s2, 16); s2 += __shfl_xor(s2, 32);
                    if (fq == 0) *(f32x2*)(stat + ((size_t)row * 64 + (u.pn - 16) * 4 + wc) * 2) = (f32x2){s1, s2};
                }
            }
    }
};
template <int MODE> struct EpiRes {
    static constexpr bool PERM = true, AFTER_DRAIN = false;
    const float* xa; const float* xb; const f32x2* rs; const float* lng; const float* lnb;
    bf16_t* H; float* stat;
    __device__ __forceinline__ void operator()(const pg8::f32x4 (&acc)[2][2][4][2], const pg8::Unit& u, int wr, int wc, int fr, int fq) const { run<0, 2>(acc, u, wr, wc, fr, fq); }
    template <int AI0, int AI1> __device__ __forceinline__ void run(const pg8::f32x4 (&acc)[2][2][4][2], const pg8::Unit& u, int wr, int wc, int fr, int fq) const {
        const int row0 = u.pm * 256 + wr * 64 + fr, col0 = u.pn * 256 + wc * 32 + 8 * fq;
        const float* xbase = nullptr;
        if (MODE == 0) xbase = (u.pm < MP / 256) ? xa + (size_t)row0 * D : xb + (size_t)(row0 - MP) * D;
        float s1[8], s2[8];
#pragma unroll
        for (int i = 0; i < 8; ++i) { s1[i] = 0.f; s2[i] = 0.f; }
#pragma unroll
        for (int bj = 0; bj < 2; ++bj) {
            f32x4 g0, g1, b0, b1;
            if (MODE == 1) { const float* gp = lng + col0 + bj * 128; const float* bp = lnb + col0 + bj * 128; g0 = *(const f32x4*)gp; g1 = *(const f32x4*)(gp + 4); b0 = *(const f32x4*)bp; b1 = *(const f32x4*)(bp + 4); }
#pragma unroll
            for (int ai = AI0; ai < AI1; ++ai)
#pragma unroll
                for (int m = 0; m < 4; ++m) {
                    const int ro = ai * 128 + m * 16;
                    bf16_t* hp = H + (size_t)(row0 + ro) * D + col0 + bj * 128;
                    f32x4 x0, x1;
                    if (MODE == 0) { const float* xp = xbase + (size_t)ro * D + col0 + bj * 128; x0 = *(const f32x4*)xp; x1 = *(const f32x4*)(xp + 4); }
                    else { const f32x2 st = rs[row0 + ro]; const u32x4 hw = *(const u32x4*)hp;
                        x0 = ((f32x4){bflo(hw.x), bfhi(hw.x), bflo(hw.y), bfhi(hw.y)} - st[0]) * st[1] * g0 + b0; x1 = ((f32x4){bflo(hw.z), bfhi(hw.z), bflo(hw.w), bfhi(hw.w)} - st[0]) * st[1] * g1 + b1; }
                    const f32x4 h0 = x0 * ALPHA + acc[ai][bj][m][0], h1 = x1 * ALPHA + acc[ai][bj][m][1];
                    *(u32x4*)hp = (u32x4){pk2(h0[0], h0[1]), pk2(h0[2], h0[3]), pk2(h1[0], h1[1]), pk2(h1[2], h1[3])};
#pragma unroll
                    for (int j = 0; j < 4; ++j) { s1[ai * 4 + m] += h0[j] + h1[j]; s2[ai * 4 + m] += h0[j] * h0[j] + h1[j] * h1[j]; }
                    asm volatile("" ::: "memory");
                }
        }
#pragma unroll
        for (int i = AI0 * 4; i < AI1 * 4; ++i) {
            float a = s1[i], q = s2[i];
            a += __shfl_xor(a, 16); a += __shfl_xor(a, 32); q += __shfl_xor(q, 16); q += __shfl_xor(q, 32);
            if (fq == 0) *(f32x2*)(stat + ((size_t)(row0 + (i >> 2) * 128 + (i & 3) * 16) * 64 + u.pn * 4 + wc) * 2) = (f32x2){a, q};
        }
    }
};
struct EpiNull {
    static constexpr bool PERM = true, AFTER_DRAIN = false;
    float* sink;
    __device__ __forceinline__ void operator()(const pg8::f32x4 (&acc)[2][2][4][2], const pg8::Unit& u, int wr, int wc, int fr, int fq) const {
        float s = 0.f;
#pragma unroll
        for (int ai = 0; ai < 2; ++ai)
#pragma unroll
            for (int bj = 0; bj < 2; ++bj)
#pragma unroll
                for (int m = 0; m < 4; ++m)
#pragma unroll
                    for (int n = 0; n < 2; ++n) s += acc[ai][bj][m][n][0] + acc[ai][bj][m][n][1] + acc[ai][bj][m][n][2] + acc[ai][bj][m][n][3];
        if (s == 12345.678f) sink[u.pm * 64 + fr] = s;
    }
};
constexpr int CW_Q = 8192, CW_CV = 16384;
struct QueueOrder {
    pg8::StaticOrder b; unsigned* q; int x; volatile LAS int* slot; int bid, nloc;
    __device__ __forceinline__ int issue(int i, int wid, int lane) const {
        int L = -1;
        if (wid == 0 && lane == 0) {
            if (i == 0 && nloc) return bid < b.cap ? bid : -1;
            for (int y = 0; y < 8; ++y) {
                const int x2 = (x + y) & 7; const unsigned t = (unsigned)nloc + __hip_atomic_fetch_add(q + 64 * x2, 1u, __ATOMIC_RELAXED, __HIP_MEMORY_SCOPE_AGENT);
                const long Lc = (long)t * 8 + x2; if (Lc < b.cap) { L = (int)Lc; break; }
            }
        }
        return L;
    }
    __device__ __forceinline__ bool resolve(int L, int i, pg8::Unit& u, int wid, int lane) const {
        if (wid == 0 && lane == 0) slot[i & 1] = L;
        asm volatile("s_waitcnt lgkmcnt(0)" ::: "memory"); __builtin_amdgcn_s_barrier(); asm volatile("" ::: "memory");
        const int Lr = __builtin_amdgcn_readfirstlane(slot[i & 1]);
        return Lr >= 0 && b.unit_of(Lr, u);
    }
    __device__ __forceinline__ void a_ready(const pg8::Unit&) const {}
    __device__ __forceinline__ void done(const pg8::Unit&) const {}
};
__device__ __forceinline__ QueueOrder make_queue(const Ctx& C, unsigned char* ws_, int pid, int Mr, int Nc) {
    QueueOrder S; S.b.init(Mr, Nc, C.G, 0); S.q = (unsigned*)(ws_ + WS_CTL) + CW_Q + pid * 8 * 64; S.x = C.bid & 7; S.slot = (volatile LAS int*)(C.lds + MISC_OFF) + 16; S.bid = C.bid; S.nloc = (C.G & 7) ? 0 : (C.G >> 3); return S;
}
struct SplitOrder {
    pg8::StaticOrder b; long L;
    __device__ bool next(int i, pg8::Unit& u) const { return i == 0 && b.unit_of(L, u); }
    __device__ __forceinline__ int issue(int, int, int) const { return 0; }
    __device__ __forceinline__ bool resolve(int, int i, pg8::Unit& u, int, int) const { return next(i, u); }
    __device__ __forceinline__ void a_ready(const pg8::Unit&) const {}
    __device__ __forceinline__ void done(const pg8::Unit&) const {}
};
struct EpiPartial {
    static constexpr bool PERM = true, AFTER_DRAIN = false;
    float* slab;
    __device__ __forceinline__ void operator()(const pg8::f32x4 (&acc)[2][2][4][2], const pg8::Unit&, int wr, int wc, int fr, int fq) const {
        const unsigned t = (unsigned)(((wr * 4 + wc) * 4 + fq) * 16 + fr);
#pragma unroll
        for (int ai = 0; ai < 2; ++ai)
#pragma unroll
            for (int bj = 0; bj < 2; ++bj)
#pragma unroll
                for (int m = 0; m < 4; ++m)
#pragma unroll
                    for (int n = 0; n < 2; ++n) sto<pg8::f32x4>(slab, ((unsigned)((((ai * 2 + bj) * 4 + m) * 2 + n) * 512) + t) * 16u, acc[ai][bj][m][n]);
    }
};
struct EpiUpConv {
    static constexpr bool PERM = true, AFTER_DRAIN = false;
    bf16_t* HG; bf16_t* SIDE; float* cp; float* cs; const float* cw; const float* cb;
    __device__ __forceinline__ void operator()(const pg8::f32x4 (&acc)[2][2][4][2], const pg8::Unit& u, int wr, int wc, int fr, int fq) const {
        const int row0 = u.pm * 256 + wr * 64 + fr, ch0 = u.pn * 128 + wc * 32 + 8 * fq;
        const int lane = fq * 16 + fr, L1 = (lane & 48) | ((fr - 1) & 15), L2 = (lane & 48) | ((fr - 2) & 15);
        f32x4 w0[2], w1[2], w2[2], bb[2];
#pragma unroll
        for (int n = 0; n < 2; ++n) { w0[n] = *(const f32x4*)(cw + ch0 + 4 * n); w1[n] = *(const f32x4*)(cw + DFF + ch0 + 4 * n); w2[n] = *(const f32x4*)(cw + 2 * DFF + ch0 + 4 * n); bb[n] = *(const f32x4*)(cb + ch0 + 4 * n); }
#pragma unroll
        for (int ai = 0; ai < 2; ++ai) {
            f32x4 s1p[2], s2p[2];
#pragma unroll
            for (int n = 0; n < 2; ++n) { s1p[n] = (f32x4){0.f, 0.f, 0.f, 0.f}; s2p[n] = s1p[n]; }
#pragma unroll
            for (int m = 0; m < 4; ++m) {
                const int row = row0 + ai * 128 + m * 16, t = row & 31;
                u32x2 ow[2];
#pragma unroll
                for (int n = 0; n < 2; ++n) {
                    const pg8::f32x4 a = acc[ai][0][m][n], uu = acc[ai][1][m][n];
                    f32x4 s1, s2, o;
#pragma unroll
                    for (int j = 0; j < 4; ++j) { s1[j] = __shfl(a[j], L1); s2[j] = __shfl(a[j], L2); }
#pragma unroll
                    for (int j = 0; j < 4; ++j) {
                        const float p1 = fr >= 1 ? s1[j] : s1p[n][j], p2 = fr >= 2 ? s2[j] : s2p[n][j];
                        const float c = bb[n][j] + p2 * w0[n][j] + p1 * w1[n][j] + a[j] * w2[n][j];
                        o[j] = fsilu(c) * uu[j];
                    }
                    s1p[n] = s1; s2p[n] = s2;
                    ow[n].x = pk2(o[0], o[1]); ow[n].y = pk2(o[2], o[3]);
                }
                const bool inwave = (m == 2) && (u.pm < MP / 256);
                if (t >= 2 || inwave) *(u32x4*)(HG + (size_t)row * DFF + ch0) = (u32x4){ow[0].x, ow[0].y, ow[1].x, ow[1].y};
                if ((t < 2 && !inwave) || t >= 30) {
                    const pg8::f32x4 a0 = acc[ai][0][m][0], a1 = acc[ai][0][m][1];
                    bf16_t* sd = SIDE + ((size_t)(row >> 5) * 6 + (t >= 30 ? t - 30 : t + 2)) * DFF + ch0;
                    *(u32x4*)sd = (u32x4){pk2(a0[0], a0[1]), pk2(a0[2], a0[3]), pk2(a1[0], a1[1]), pk2(a1[2], a1[3])};
                    if (t < 2) { const pg8::f32x4 u0 = acc[ai][1][m][0], u1 = acc[ai][1][m][1];
                        *(u32x4*)(sd + 2 * DFF) = (u32x4){pk2(u0[0], u0[1]), pk2(u0[2], u0[3]), pk2(u1[0], u1[1]), pk2(u1[2], u1[3])}; }
                    float* dst = nullptr;
                    if (row < MP) { const int tq = row & 4095; if (tq >= 4094) dst = cp + ((size_t)(row >> 12) * 2 + (tq - 4094)) * DFF + ch0; }
                    else if (t >= 30) dst = cs + ((size_t)((row - MP) >> 5) * 2 + (t - 30)) * DFF + ch0;
                    if (dst) { *(f32x4*)dst = a0; *(f32x4*)(dst + 4) = a1; }
                }
            }
        }
    }
};
struct EpiBin {
    static constexpr bool PERM = true, AFTER_DRAIN = false;
    unsigned char* ws;
    __device__ __forceinline__ void operator()(const pg8::f32x4 (&acc)[2][2][4][2], const pg8::Unit& u, int wr, int wc, int fr, int fq) const {
        const int row0 = u.pm * 256 + wr * 64 + fr;
        if (u.pn >= 32) {
            const int col0 = (u.pn & 15) * 256 + wc * 32 + 8 * fq, sel = u.pn >> 4;
            bf16_t* dst = (bf16_t*)(ws + WS_Q + (size_t)sel * (136 * MiB));
#pragma unroll
            for (int ai = 0; ai < 2; ++ai)
#pragma unroll
                for (int m = 0; m < 4; ++m)
#pragma unroll
                    for (int bj = 0; bj < 2; ++bj) {
                        const pg8::f32x4 v0 = acc[ai][bj][m][0], v1 = acc[ai][bj][m][1];
                        u32x4 w; w.x = pk2(v0[0], v0[1]); w.y = pk2(v0[2], v0[3]); w.z = pk2(v1[0], v1[1]); w.w = pk2(v1[2], v1[3]);
                        *(u32x4*)(dst + (size_t)(row0 + ai * 128 + m * 16) * D + col0 + bj * 128) = w;
                    }
            return;
        }
        const int ch0 = u.pn * 128 + wc * 32 + 8 * fq;
        bf16_t* QS = (bf16_t*)(ws + WS_QS); bf16_t* KD = (bf16_t*)(ws + WS_KD); float* DCH = (float*)(ws + WS_DCH); const float* LB = (const float*)(ws + WS_LB);
        const f32x4 lb0 = *(const f32x4*)(LB + ch0), lb1 = *(const f32x4*)(LB + ch0 + 4);
        const int l15 = (fq * 16 + 15) * 4;
#pragma unroll
        for (int ai = 0; ai < 2; ++ai)
#pragma unroll
            for (int mp = 0; mp < 2; ++mp) {
                unsigned wq0[4], wq1[4], wk0[4], wk1[4];
#pragma unroll
                for (int n = 0; n < 2; ++n) {
                    const f32x4 lb = n ? lb1 : lb0;
                    float k0[4], k1[4], b0[4], b1[4];
#pragma unroll
                    for (int j = 0; j < 4; ++j) {
                        const float om = 1.0f - lb[j];
                        const float e0 = fexp(-acc[ai][1][2 * mp][n][j]), e1 = fexp(-acc[ai][1][2 * mp + 1][n][j]);
                        const float r0 = frcp(1.0f + e0), r1 = frcp(1.0f + e1);
                        k0[j] = om * e0 * r0; k1[j] = om * e1 * r1;
                        b0[j] = __builtin_amdgcn_logf(lb[j] + om * r0); b1[j] = __builtin_amdgcn_logf(lb[j] + om * r1);
                    }
#pragma unroll
                    for (int j = 0; j < 4; ++j) {
                        b0[j] += __int_as_float(__builtin_amdgcn_update_dpp(0, __float_as_int(b0[j]), 0x111, 0xf, 0xf, true));
                        b1[j] += __int_as_float(__builtin_amdgcn_update_dpp(0, __float_as_int(b1[j]), 0x111, 0xf, 0xf, true));
                    }
#pragma unroll
                    for (int j = 0; j < 4; ++j) {
                        b0[j] += __int_as_float(__builtin_amdgcn_update_dpp(0, __float_as_int(b0[j]), 0x112, 0xf, 0xf, true));
                        b1[j] += __int_as_float(__builtin_amdgcn_update_dpp(0, __float_as_int(b1[j]), 0x112, 0xf, 0xf, true));
                    }
#pragma unroll
                    for (int j = 0; j < 4; ++j) {
                        b0[j] += __int_as_float(__builtin_amdgcn_update_dpp(0, __float_as_int(b0[j]), 0x114, 0xf, 0xf, true));
                        b1[j] += __int_as_float(__builtin_amdgcn_update_dpp(0, __float_as_int(b1[j]), 0x114, 0xf, 0xf, true));
                    }
#pragma unroll
                    for (int j = 0; j < 4; ++j) {
                        b0[j] += __int_as_float(__builtin_amdgcn_update_dpp(0, __float_as_int(b0[j]), 0x118, 0xf, 0xf, true));
                        b1[j] += __int_as_float(__builtin_amdgcn_update_dpp(0, __float_as_int(b1[j]), 0x118, 0xf, 0xf, true));
                    }
                    float qs0[4], qs1[4], kd0[4], kd1[4]; f32x4 et;
#pragma unroll
                    for (int j = 0; j < 4; ++j) {
                        b1[j] += __int_as_float(__builtin_amdgcn_ds_bpermute(l15, __float_as_int(b0[j])));
                        const float eb0 = __builtin_amdgcn_exp2f(b0[j]), eb1 = __builtin_amdgcn_exp2f(b1[j]);
                        qs0[j] = acc[ai][0][2 * mp][n][j] * eb0; qs1[j] = acc[ai][0][2 * mp + 1][n][j] * eb1;
                        kd0[j] = k0[j] * frcp(eb0); kd1[j] = k1[j] * frcp(eb1);
                        et[j] = eb1;
                    }
                    wq0[2 * n] = pk2(qs0[0], qs0[1]); wq0[2 * n + 1] = pk2(qs0[2], qs0[3]); wq1[2 * n] = pk2(qs1[0], qs1[1]); wq1[2 * n + 1] = pk2(qs1[2], qs1[3]);
                    wk0[2 * n] = pk2(kd0[0], kd0[1]); wk0[2 * n + 1] = pk2(kd0[2], kd0[3]); wk1[2 * n] = pk2(kd1[0], kd1[1]); wk1[2 * n + 1] = pk2(kd1[2], kd1[3]);
                    if (fr == 15) *(f32x4*)(DCH + (size_t)(u.pm * 8 + ai * 4 + wr * 2 + mp) * D + ch0 + 4 * n) = et;
                }
                const size_t o0 = (size_t)(row0 + ai * 128 + mp * 32) * D + ch0, o1 = o0 + (size_t)16 * D;
                u32x4 w;
                w.x = wq0[0]; w.y = wq0[1]; w.z = wq0[2]; w.w = wq0[3]; *(u32x4*)(QS + o0) = w;
                w.x = wq1[0]; w.y = wq1[1]; w.z = wq1[2]; w.w = wq1[3]; *(u32x4*)(QS + o1) = w;
                w.x = wk0[0]; w.y = wk0[1]; w.z = wk0[2]; w.w = wk0[3]; *(u32x4*)(KD + o0) = w;
                w.x = wk1[0]; w.y = wk1[1]; w.z = wk1[2]; w.w = wk1[3]; *(u32x4*)(KD + o1) = w;
            }
    }
};

struct CvItem { const float* src; bf16_t* dst; int K, N; };
__device__ __forceinline__ void cv_load(const CvItem& d, int lane, f32x4 (&x)[16]) {
    const unsigned lo = (unsigned)((lane >> 4) * d.N + 4 * (lane & 15)) * 4u, step = (unsigned)d.N * 16u;
#pragma unroll
    for (int i = 0; i < 16; ++i) x[i] = __builtin_nontemporal_load((const f32x4*)((const char*)d.src + lo + (unsigned)i * step));
}
__device__ __forceinline__ void cv_store(const CvItem& d, int lane, const f32x4 (&x)[16], LAS float* scr) {
#pragma unroll
    for (int i = 0; i < 16; ++i) {
        LAS float* p = scr + (4 * i + (lane >> 4)) * 65 + 4 * (lane & 15);
        p[0] = x[i][0]; p[1] = x[i][1]; p[2] = x[i][2]; p[3] = x[i][3];
    }
    LDS_WAIT();
    const int c = lane & 7;
#pragma unroll
    for (int j = 0; j < 8; ++j) {
        const int n = (lane >> 3) + 8 * j; const LAS float* s = scr + (8 * c) * 65 + n;
        u32x4 o; o.x = pk2(s[0], s[65]); o.y = pk2(s[2 * 65], s[3 * 65]); o.z = pk2(s[4 * 65], s[5 * 65]); o.w = pk2(s[6 * 65], s[7 * 65]);
        __builtin_nontemporal_store(o, (u32x4*)((char*)d.dst + (unsigned)(n * d.K + 8 * c) * 2u));
    }
    LDS_WAIT();
}
constexpr int I_AIN = 64 * 128, I_AOUT = 64 * 64, I_BIN = 64 * 256, I_BOUT = 64 * 64, I_UP = 64 * 344, I_DN = 172 * 64;
constexpr int CV_DN0A = 7400, CV_UP0A = 6000;
constexpr int CV_S0 = 0;
constexpr int CV_S1 = CV_S0 + I_AIN + CV_DN0A;
constexpr int CV_S2 = CV_S1 + I_AOUT + CV_UP0A;
constexpr int CV_S3 = CV_S2 + (I_UP - CV_UP0A);
constexpr int CV_S4 = CV_S3 + (I_DN - CV_DN0A);
constexpr int CV_S4B = CV_S4 + I_BIN + I_BOUT + I_UP / 2;
constexpr int CV_S5 = CV_S4B + I_UP - I_UP / 2;
constexpr int CV_END = CV_S5 + I_DN;
__device__ __forceinline__ CvItem cv_decode(const Ctx& C, unsigned char* ws_, int it) {
    int r = it; const float* W; bf16_t* WT; int K, N, kind = 0;
    if (r < I_AIN) { W = inp(C, 4); WT = (bf16_t*)(ws_ + WS_W_AIN); K = D; N = NAIN; }
    else if ((r -= I_AIN) < CV_DN0A) { W = inp(C, 17); WT = (bf16_t*)(ws_ + WS_W_DN0); K = DFF; N = D; }
    else if ((r -= CV_DN0A) < I_AOUT) { W = inp(C, 9); WT = (bf16_t*)(ws_ + WS_W_AOUT); K = D; N = D; }
    else if ((r -= I_AOUT) < I_UP) { W = inp(C, 14); WT = (bf16_t*)(ws_ + WS_W_UP0); K = D; N = NUP; kind = 1; }
    else if ((r -= I_UP) < I_DN - CV_DN0A) { r += CV_DN0A; W = inp(C, 17); WT = (bf16_t*)(ws_ + WS_W_DN0); K = DFF; N = D; }
    else if ((r -= I_DN - CV_DN0A) < I_BIN) { W = inp(C, 10); WT = (bf16_t*)(ws_ + WS_W_BIN); K = D; N = NBIN; kind = 2; }
    else if ((r -= I_BIN) < I_BOUT) { W = inp(C, 13); WT = (bf16_t*)(ws_ + WS_W_BOUT); K = D; N = D; }
    else if ((r -= I_BOUT) < I_UP) { W = inp(C, 14) + (size_t)D * NUP; WT = (bf16_t*)(ws_ + WS_W_UP1); K = D; N = NUP; kind = 1; }
    else { r -= I_UP; W = inp(C, 17) + (size_t)DFF * D; WT = (bf16_t*)(ws_ + WS_W_DN1); K = DFF; N = D; }
    const int nblk = N / 64, kb = r / nblk, nb = r % nblk, n0 = nb * 64;
    int drow0 = n0;
    if (kind == 1) { const int h = n0 >= DFF ? 1 : 0, c = n0 - h * DFF; drow0 = 256 * (c >> 7) + 128 * h + (c & 127); }
    if (kind == 2 && n0 < 2 * D) { const int h = n0 >= D ? 1 : 0, c = n0 - h * D; drow0 = 256 * (c >> 7) + 128 * h + (c & 127); }
    CvItem d; d.src = W + (size_t)(kb * 64) * N + n0; d.dst = WT + (size_t)drow0 * K + kb * 64; d.K = K; d.N = N; return d;
}
__device__ __forceinline__ void conv_range(const Ctx& C, int lo, int hi, int rank, int nranks) {
    unsigned char* const ws_ = wsp(C);
    LAS float* scr = (LAS float*)(C.lds + C.wave * 16640);
    int it = lo + rank;
    if (it >= hi) return;
    CvItem d = cv_decode(C, ws_, it); f32x4 cur[16], nxt[16];
    cv_load(d, C.lane, cur);
    for (;;) {
        const int itn = it + nranks; const bool more = itn < hi;
        CvItem dn = d;
        if (more) { dn = cv_decode(C, ws_, itn); cv_load(dn, C.lane, nxt); }
        cv_store(d, C.lane, cur, scr);
        if (!more) break;
#pragma unroll
        for (int i = 0; i < 16; ++i) cur[i] = nxt[i];
        d = dn; it = itn;
    }
}
__device__ __forceinline__ void conv_queue(const Ctx& C, int seg, int lo, int hi) {
    unsigned char* const ws_ = wsp(C);
    unsigned* ctr = (unsigned*)(ws_ + WS_CTL) + CW_CV + seg * 64;
    LAS float* scr = (LAS float*)(C.lds + C.wave * 16640);
    for (;;) {
        unsigned t = 0; if (C.lane == 0) t = __hip_atomic_fetch_add(ctr, 1u, __ATOMIC_RELAXED, __HIP_MEMORY_SCOPE_AGENT);
        t = (unsigned)__builtin_amdgcn_readfirstlane((int)t);
        const int it0 = lo + (int)t * 4; if (it0 >= hi) break;
        for (int it = it0; it < it0 + 4 && it < hi; ++it) { const CvItem d = cv_decode(C, ws_, it); f32x4 x[16]; cv_load(d, C.lane, x); cv_store(d, C.lane, x, scr); }
    }
    __syncthreads();
}
__device__ __forceinline__ void conv_tail(const Ctx& C, int nwg, int lo, int hi) {
    const int R = (nwg + C.G - 1) / C.G - 1, nbusy = nwg - R * C.G;
    if (nbusy >= C.G) conv_range(C, lo, hi, C.bid * 8 + C.wave, C.G * 8);
    else if (C.bid >= nbusy) conv_range(C, lo, hi, (C.bid - nbusy) * 8 + C.wave, (C.G - nbusy) * 8);
    __syncthreads();
}
__device__ __forceinline__ void p0_prologue(const Ctx& C0) {
    const Ctx C = C0;
    unsigned char* const ws_ = wsp(C);
    conv_range(C, CV_S0, CV_S1, C.bid * 8 + C.wave, C.G * 8);
    bf16_t* XB = (bf16_t*)(ws_ + WS_XB); const float* const xp_ = inp(C, 0); const float* const xs_ = inp(C, 1);
    for (size_t i = (size_t)C.bid * 512 + C.tid; i < (size_t)M * D / 8; i += (size_t)C.G * 512) {
        const int row = (int)(i >> 9), c8 = (int)(i & 511);
        const float* xr = xin_row(xp_, xs_, row) + c8 * 8;
        const f32x4 a = *(const f32x4*)xr, b = *(const f32x4*)(xr + 4);
        u32x4 w; w.x = pk2(a[0], a[1]); w.y = pk2(a[2], a[3]); w.z = pk2(b[0], b[1]); w.w = pk2(b[2], b[3]);
        *(u32x4*)(XB + (size_t)row * D + c8 * 8) = w;
    }
    float* LB = (float*)(ws_ + WS_LB);
    const float* const blb_ = inp(C, 11);
    for (int i = C.bid * 512 + C.tid; i < D; i += C.G * 512) { const float b0 = blb_[i], b1 = blb_[D + i]; LB[i] = 1.0f / (1.0f + expf(b0 - b1)); }
}

__device__ __forceinline__ void p_rowstat(const Ctx& C0) {
    const Ctx C = C0;
    unsigned char* const ws_ = wsp(C);
    const f32x2* stat = (const f32x2*)(ws_ + WS_STAT); f32x2* rs = (f32x2*)(ws_ + WS_ROWSTAT);
    for (int row = C.bid * 8 + C.wave; row < M; row += C.G * 8) {
        const f32x2 sl = stat[(size_t)row * 64 + C.lane];
        const float s1 = wave_sum(sl[0]), s2 = wave_sum(sl[1]);
        const float mean = s1 * (1.0f / D), var = s2 * (1.0f / D) - mean * mean;
        if (C.lane == 0) rs[row] = (f32x2){mean, 1.0f / sqrtf(var + LN_EPS)};
    }
}
__device__ __forceinline__ void p_ln_apply(const Ctx& C0, const float* g, const float* b, bf16_t* XBo, float* Yo) {
    const Ctx C = C0;
    unsigned char* const ws_ = wsp(C);
    const bf16_t* H = (const bf16_t*)(ws_ + WS_H32); const f32x2* stat = (const f32x2*)(ws_ + WS_STAT); f32x2* rs2 = (f32x2*)(ws_ + WS_RS2);
    const unsigned loff = (unsigned)C.lane * 16u;
    for (int row = C.bid * 8 + C.wave; row < M; row += C.G * 8) {
        const f32x2 sl = stat[(size_t)row * 64 + C.lane];
        const bf16_t* hr = H + (size_t)row * D;
        u32x4 hw[8];
#pragma unroll
        for (int j = 0; j < 8; ++j) hw[j] = ldo<u32x4>(hr, loff + (unsigned)j * 1024u);
        const float s1 = wave_sum(sl[0]), s2 = wave_sum(sl[1]);
        const float mean = s1 * (1.0f / D), var = s2 * (1.0f / D) - mean * mean, rstd = 1.0f / sqrtf(var + LN_EPS);
        if (C.lane == 0) rs2[row] = (f32x2){mean, rstd};
#pragma unroll
        for (int j = 0; j < 8; ++j) {
            const int c = 512 * j + 8 * C.lane;
            const f32x4 v0 = {bflo(hw[j].x), bfhi(hw[j].x), bflo(hw[j].y), bfhi(hw[j].y)}, v1 = {bflo(hw[j].z), bfhi(hw[j].z), bflo(hw[j].w), bfhi(hw[j].w)};
            const f32x4 g0 = *(const f32x4*)(g + c), g1 = *(const f32x4*)(g + c + 4), b0 = *(const f32x4*)(b + c), b1 = *(const f32x4*)(b + c + 4);
            const f32x4 y0 = (v0 - mean) * rstd * g0 + b0, y1 = (v1 - mean) * rstd * g1 + b1;
            if (Yo) { __builtin_nontemporal_store(y0, (f32x4*)(Yo + (size_t)row * D + c)); __builtin_nontemporal_store(y1, (f32x4*)(Yo + (size_t)row * D + c + 4)); }
            if (XBo) { u32x4 w; w.x = pk2(y0[0], y0[1]); w.y = pk2(y0[2], y0[3]); w.z = pk2(y1[0], y1[1]); w.w = pk2(y1[2], y1[3]); *(u32x4*)(XBo + (size_t)row * D + c) = w; }
        }
    }
}
__device__ __forceinline__ void p_convfix(const Ctx& C0, int layer) {
    const Ctx C = C0;
    unsigned char* const ws_ = wsp(C);
    const bf16_t* SIDE = (const bf16_t*)(ws_ + WS_SIDE); bf16_t* HG = (bf16_t*)(ws_ + WS_HG);
    const float* cw = inp(C, 15) + (size_t)layer * 3 * DFF; const float* cb = inp(C, 16) + (size_t)layer * DFF;
    const float* cache = inp(C, 3) + (size_t)layer * 32 * 2 * DFF;
    constexpr int NCH = DFF / 8, NCK = MP / 64 + (M - MP) / 32;
    for (int task = C.bid * 512 + C.tid; task < NCK * NCH; task += C.G * 512) {
        const int ki = task / NCH, q = task - ki * NCH, c = 8 * q, k = ki < MP / 64 ? 2 * ki : MP / 32 + (ki - MP / 64);
        float w0[8], w1[8], w2[8], bb[8], p1[8], p2[8], a0[8], a1[8], u0[8], u1[8];
#pragma unroll
        for (int j = 0; j < 8; ++j) { w0[j] = cw[c + j]; w1[j] = cw[DFF + c + j]; w2[j] = cw[2 * DFF + c + j]; bb[j] = cb[c + j]; p1[j] = 0.f; p2[j] = 0.f; }
        if (k >= MP / 32) {
            const float* cs = cache + (size_t)(k - MP / 32) * 2 * DFF + c;
#pragma unroll
            for (int j = 0; j < 8; ++j) { p2[j] = cs[j]; p1[j] = cs[DFF + j]; }
        } else if ((k & 127) != 0) {
            const u32x4 x2 = *(const u32x4*)(SIDE + ((size_t)(k - 1) * 6 + 0) * DFF + c), x1 = *(const u32x4*)(SIDE + ((size_t)(k - 1) * 6 + 1) * DFF + c);
#pragma unroll
            for (int j = 0; j < 4; ++j) { p2[2 * j] = bflo(x2[j]); p2[2 * j + 1] = bfhi(x2[j]); p1[2 * j] = bflo(x1[j]); p1[2 * j + 1] = bfhi(x1[j]); }
        }
        const bf16_t* sd = SIDE + (size_t)k * 6 * DFF + c;
        const u32x4 xa0 = *(const u32x4*)(sd + 2 * DFF), xa1 = *(const u32x4*)(sd + 3 * DFF), xu0 = *(const u32x4*)(sd + 4 * DFF), xu1 = *(const u32x4*)(sd + 5 * DFF);
#pragma unroll
        for (int j = 0; j < 4; ++j) { a0[2 * j] = bflo(xa0[j]); a0[2 * j + 1] = bfhi(xa0[j]); a1[2 * j] = bflo(xa1[j]); a1[2 * j + 1] = bfhi(xa1[j]);
                                       u0[2 * j] = bflo(xu0[j]); u0[2 * j + 1] = bfhi(xu0[j]); u1[2 * j] = bflo(xu1[j]); u1[2 * j + 1] = bfhi(xu1[j]); }
        float o0[8], o1[8];
#pragma unroll
        for (int j = 0; j < 8; ++j) {
            const float c0 = bb[j] + p2[j] * w0[j] + p1[j] * w1[j] + a0[j] * w2[j];
            const float c1 = bb[j] + p1[j] * w0[j] + a0[j] * w1[j] + a1[j] * w2[j];
            o0[j] = fsilu(c0) * u0[j]; o1[j] = fsilu(c1) * u1[j];
        }
        *(u32x4*)(HG + (size_t)(32 * k) * DFF + c) = (u32x4){pk2(o0[0], o0[1]), pk2(o0[2], o0[3]), pk2(o0[4], o0[5]), pk2(o0[6], o0[7])};
        *(u32x4*)(HG + (size_t)(32 * k + 1) * DFF + c) = (u32x4){pk2(o1[0], o1[1]), pk2(o1[2], o1[3]), pk2(o1[4], o1[5]), pk2(o1[6], o1[7])};
    }
}

constexpr int SG_WS = 0, SG_VN = 34816, SG_MX = 69632, SG_ROW = 272, SG_MXROW = 528;
__device__ __forceinline__ void p_spatial(const Ctx& C0) {
    const Ctx C = C0;
    unsigned char* const ws_ = wsp(C); float* const out_ = outp(C);
    const bf16_t* Z = (const bf16_t*)(ws_ + WS_Z); bf16_t* GATED = (bf16_t*)(ws_ + WS_GATED);
    const f32x2* rs = (const f32x2*)(ws_ + WS_ROWSTAT);
    const float* w_s = inp(C, 7); const float* b_s = inp(C, 8); const float* ln_g = inp(C, 5); const float* ln_b = inp(C, 6);
    LAS unsigned char* lds = C.lds;
    const int tid = C.tid, lane = C.lane, wave = C.wave, wr = wave >> 2, wc = wave & 3, c16 = lane & 15, hh = lane >> 4, q4 = (lane & 15) >> 2, p4 = lane & 3;
    int cur_g = -1, cur_type = -1;
    float lg[8], lbv[8], bsv[4];
    for (int u = C.bid; u < (M / 128) * 32; u += C.G) {
        const int rb = u >> 5, g = u & 31, r0 = rb * 128, type = (r0 >= MP) ? 1 : 0;
        u32x4 U16[4], V16[4]; f32x2 st[4];
        const int c8 = tid & 15;
#pragma unroll
        for (int k = 0; k < 4; ++k) {
            const int t = (tid >> 4) + 32 * k;
            const bf16_t* zr = Z + (size_t)(r0 + t) * NAIN + g * 128 + c8 * 8;
            U16[k] = *(const u32x4*)zr; V16[k] = *(const u32x4*)(zr + D); st[k] = rs[r0 + t];
        }
        if (g != cur_g || type != cur_type) {
            __syncthreads();
            const int t = tid >> 2, sq = tid & 3;
#pragma unroll
            for (int s8 = 0; s8 < 4; ++s8) {
                const int s0 = 32 * sq + 8 * s8; float wv[8];
                if (type == 0) {
                    const float* src = w_s + ((size_t)g * 128 + t) * 128 + s0;
                    const f32x4 a = *(const f32x4*)src, b = *(const f32x4*)(src + 4);
#pragma unroll
                    for (int j = 0; j < 4; ++j) { wv[j] = (s0 + j <= t) ? a[j] : 0.f; wv[4 + j] = (s0 + 4 + j <= t) ? b[j] : 0.f; }
                } else {
                    const int tl = t & 31, sl = s0 & 31; const bool same = (t >> 5) == (s0 >> 5);
                    const float* src = w_s + ((size_t)g * 128 + tl) * 128 + sl;
                    const f32x4 a = *(const f32x4*)src, b = *(const f32x4*)(src + 4);
#pragma unroll
                    for (int j = 0; j < 4; ++j) { wv[j] = (same && sl + j <= tl) ? a[j] : 0.f; wv[4 + j] = (same && sl + 4 + j <= tl) ? b[j] : 0.f; }
                }
                u32x4 w; w.x = pk2(wv[0], wv[1]); w.y = pk2(wv[2], wv[3]); w.z = pk2(wv[4], wv[5]); w.w = pk2(wv[6], wv[7]);
                *(LAS u32x4*)(lds + SG_WS + t * SG_ROW + s0 * 2) = w;
            }
#pragma unroll
            for (int j = 0; j < 8; ++j) { lg[j] = ln_g[g * 128 + c8 * 8 + j]; lbv[j] = ln_b[g * 128 + c8 * 8 + j]; }
#pragma unroll
            for (int tt = 0; tt < 4; ++tt) { const int t2 = 64 * wr + 16 * tt + c16; bsv[tt] = b_s[g * 128 + (type ? (t2 & 31) : t2)]; }
            cur_g = g; cur_type = type;
        }
#pragma unroll
        for (int k = 0; k < 4; ++k) {
            const int t = (tid >> 4) + 32 * k; float vn[8];
#pragma unroll
            for (int j = 0; j < 4; ++j) {
                vn[2 * j] = (bflo(V16[k][j]) - st[k][0]) * st[k][1] * lg[2 * j] + lbv[2 * j];
                vn[2 * j + 1] = (bfhi(V16[k][j]) - st[k][0]) * st[k][1] * lg[2 * j + 1] + lbv[2 * j + 1];
            }
            if (type) { float* nv = out_ + OUT_NV + (size_t)(r0 + t - MP) * D + g * 128 + c8 * 8;
                *(f32x4*)nv = (f32x4){vn[0], vn[1], vn[2], vn[3]}; *(f32x4*)(nv + 4) = (f32x4){vn[4], vn[5], vn[6], vn[7]}; }
            u32x4 w; w.x = pk2(vn[0], vn[1]); w.y = pk2(vn[2], vn[3]); w.z = pk2(vn[4], vn[5]); w.w = pk2(vn[6], vn[7]);
            *(LAS u32x4*)(lds + SG_VN + t * SG_ROW + c8 * 16) = w;
        }
        __syncthreads();
        f32x4 acc[2][4];
#pragma unroll
        for (int ct = 0; ct < 2; ++ct)
#pragma unroll
            for (int tt = 0; tt < 4; ++tt) acc[ct][tt] = (f32x4){0.f, 0.f, 0.f, 0.f};
#pragma unroll
        for (int kk = 0; kk < 4; ++kk) {
            bf16x8 a[2], b[4];
#pragma unroll
            for (int ct = 0; ct < 2; ++ct) {
                LAS unsigned char* p = lds + SG_VN + (32 * kk + 8 * hh + q4) * SG_ROW + (32 * wc + 16 * ct + 4 * p4) * 2;
                a[ct] = cat4(lds_tr(p), lds_tr(p + 4 * SG_ROW));
            }
#pragma unroll
            for (int tt = 0; tt < 4; ++tt) b[tt] = *(const LAS bf16x8*)(lds + SG_WS + (64 * wr + 16 * tt + c16) * SG_ROW + (32 * kk + 8 * hh) * 2);
#pragma unroll
            for (int ct = 0; ct < 2; ++ct)
#pragma unroll
                for (int tt = 0; tt < 4; ++tt) acc[ct][tt] = __builtin_amdgcn_mfma_f32_16x16x32_bf16(a[ct], b[tt], acc[ct][tt], 0, 0, 0);
        }
#pragma unroll
        for (int ct = 0; ct < 2; ++ct)
#pragma unroll
            for (int tt = 0; tt < 4; ++tt)
                *(LAS f32x4*)(lds + SG_MX + (64 * wr + 16 * tt + c16) * SG_MXROW + (32 * wc + 16 * ct + 4 * hh) * 4) = acc[ct][tt] + bsv[tt];
        __syncthreads();
#pragma unroll
        for (int k = 0; k < 4; ++k) {
            const int t = (tid >> 4) + 32 * k;
            const f32x4 m0 = *(const LAS f32x4*)(lds + SG_MX + t * SG_MXROW + c8 * 32), m1 = *(const LAS f32x4*)(lds + SG_MX + t * SG_MXROW + c8 * 32 + 16);
            u32x4 w;
            w.x = pk2(bflo(U16[k][0]) * m0[0], bfhi(U16[k][0]) * m0[1]); w.y = pk2(bflo(U16[k][1]) * m0[2], bfhi(U16[k][1]) * m0[3]);
            w.z = pk2(bflo(U16[k][2]) * m1[0], bfhi(U16[k][2]) * m1[1]); w.w = pk2(bflo(U16[k][3]) * m1[2], bfhi(U16[k][3]) * m1[3]);
            *(u32x4*)(GATED + (size_t)(r0 + t) * D + g * 128 + c8 * 8) = w;
        }
    }
    __syncthreads();
}


#ifndef GLA_PROMPT_REPS
#define GLA_PROMPT_REPS 1
#endif
constexpr int GL_QS = 0, GL_KD = 8704, GL_V = 17408, GL_G = 26112, GL_DCH = 34816, GL_BUF = 35328, GL_OT = 2 * GL_BUF, GL_OTSZ = 32 * 528, GL_ROW = 272, GL_OTROW = 528;
#define GLA_NORM(PK, GATE) do { const int pk_ = (PK); \
            LAS unsigned char* OTp = lds + GL_OT + (pk_ & 1) * GL_OTSZ; const int orow = 4 * w + hh; \
            const f32x4 x0 = *(const LAS f32x4*)(OTp + orow * GL_OTROW + c16 * 32), x1 = *(const LAS f32x4*)(OTp + orow * GL_OTROW + c16 * 32 + 16); \
            float ss = x0[0] * x0[0] + x0[1] * x0[1] + x0[2] * x0[2] + x0[3] * x0[3] + x1[0] * x1[0] + x1[1] * x1[1] + x1[2] * x1[2] + x1[3] * x1[3]; \
            ss += __shfl_xor(ss, 1); ss += __shfl_xor(ss, 2); ss += __shfl_xor(ss, 4); ss += __shfl_xor(ss, 8); \
            const float rn = 1.0f / sqrtf(ss * (1.0f / 128.0f) + RMS_EPS); \
            u32x4 wv; \
            wv.x = pk2(x0[0] * rn * g0[0] * fsilu(bflo(GATE[0])), x0[1] * rn * g0[1] * fsilu(bfhi(GATE[0]))); \
            wv.y = pk2(x0[2] * rn * g0[2] * fsilu(bflo(GATE[1])), x0[3] * rn * g0[3] * fsilu(bfhi(GATE[1]))); \
            wv.z = pk2(x1[0] * rn * g1[0] * fsilu(bflo(GATE[2])), x1[1] * rn * g1[1] * fsilu(bfhi(GATE[2]))); \
            wv.w = pk2(x1[2] * rn * g1[2] * fsilu(bflo(GATE[3])), x1[3] * rn * g1[3] * fsilu(bfhi(GATE[3]))); \
            sto<u32x4>(O + (size_t)(rbase + 32 * pk_) * D + cb, ooff, wv); } while (0)
#define GLA_STEP(CKV, WRSET, LDSET) do { const int ck = (CKV); \
            LAS unsigned char* B = lds + (ck & 1) * GL_BUF; \
            LAS unsigned char* OT = lds + GL_OT + (ck & 1) * GL_OTSZ; \
            const int r0 = rbase + 32 * ck; \
            const bool more = ck + 1 < nck; \
            const size_t uo = (size_t)r0 * D + cb; \
            { const int c2 = ck + 2 < nck ? ck + 2 : nck - 1;     \
              const size_t u2 = (size_t)(rbase + 32 * c2) * D + cb; LDSET##a = ldo<u32x4>(QS + u2, soff); LDSET##b = ldo<u32x4>(KD + u2, soff); LDSET##d = ldo<u32x4>(V + u2, soff); LDSET##e = ldo<u32x4>(Gt + u2, soff); \
              if (w == 0) LDSET##f = ldo<f32x4>(DCH + (size_t)((rbase >> 5) + c2) * D + cb, (unsigned)(tid & 31) * 16u); }     \
            f32x4 dch[8]; \
_Pragma("unroll") \
            for (int i = 0; i < 8; ++i) dch[i] = *(const LAS f32x4*)(B + GL_DCH + (16 * i + 4 * hh) * 4); \
            f32x4 a00 = {0.f, 0.f, 0.f, 0.f}, a01 = a00, a11 = a00; \
_Pragma("unroll") \
            for (int kk = 0; kk < 4; ++kk) { \
                const int co = (32 * kk + 8 * hh) * 2; \
                const bf16x8 k0 = *(const LAS bf16x8*)(B + GL_KD + c16 * GL_ROW + co), k1 = *(const LAS bf16x8*)(B + GL_KD + (16 + c16) * GL_ROW + co); \
                const bf16x8 q0 = *(const LAS bf16x8*)(B + GL_QS + c16 * GL_ROW + co), q1 = *(const LAS bf16x8*)(B + GL_QS + (16 + c16) * GL_ROW + co); \
                a00 = __builtin_amdgcn_mfma_f32_16x16x32_bf16(k0, q0, a00, 0, 0, 0); \
                a01 = __builtin_amdgcn_mfma_f32_16x16x32_bf16(k0, q1, a01, 0, 0, 0); \
                a11 = __builtin_amdgcn_mfma_f32_16x16x32_bf16(k1, q1, a11, 0, 0, 0); \
            } \
            if (ck > 0) GLA_NORM(ck - 1, gprev); \
            gprev = *(const LAS u32x4*)(B + GL_G + (4 * w + hh) * GL_ROW + c16 * 16); \
_Pragma("unroll") \
            for (int r = 0; r < 4; ++r) { if (4 * hh + r > c16) { a00[r] = 0.f; a11[r] = 0.f; } } \
            bf16x8 P0, P1; \
            { u32x4 t; t.x = pk2(a00[0], a00[1]); t.y = pk2(a00[2], a00[3]); t.z = 0u; t.w = 0u; P0 = __builtin_bit_cast(bf16x8, t); } \
            { u32x4 t; t.x = pk2(a01[0], a01[1]); t.y = pk2(a01[2], a01[3]); t.z = pk2(a11[0], a11[1]); t.w = pk2(a11[2], a11[3]); P1 = __builtin_bit_cast(bf16x8, t); } \
            LAS unsigned char* vp = B + GL_V + (4 * hh + q4) * GL_ROW + (16 * w + 4 * p4) * 2; \
            const bf16x8 vB = cat4(lds_tr(vp), lds_tr(vp + 16 * GL_ROW)); \
            f32x4 o0 = {0.f, 0.f, 0.f, 0.f}, o1 = o0; \
            o0 = __builtin_amdgcn_mfma_f32_16x16x32_bf16(P0, vB, o0, 0, 0, 0); \
            o1 = __builtin_amdgcn_mfma_f32_16x16x32_bf16(P1, vB, o1, 0, 0, 0); \
_Pragma("unroll") \
            for (int kk = 0; kk < 4; ++kk) { \
                u32x4 sb; sb.x = pk2(S[2 * kk][0], S[2 * kk][1]); sb.y = pk2(S[2 * kk][2], S[2 * kk][3]); sb.z = pk2(S[2 * kk + 1][0], S[2 * kk + 1][1]); sb.w = pk2(S[2 * kk + 1][2], S[2 * kk + 1][3]); \
                const bf16x8 bS = __builtin_bit_cast(bf16x8, sb); \
                const int co = (32 * kk + 4 * hh) * 2; \
                const s16x4 x0 = *(const LAS s16x4*)(B + GL_QS + c16 * GL_ROW + co), x1 = *(const LAS s16x4*)(B + GL_QS + c16 * GL_ROW + co + 32); \
                const s16x4 y0 = *(const LAS s16x4*)(B + GL_QS + (16 + c16) * GL_ROW + co), y1 = *(const LAS s16x4*)(B + GL_QS + (16 + c16) * GL_ROW + co + 32); \
                o0 = __builtin_amdgcn_mfma_f32_16x16x32_bf16(cat4(x0, x1), bS, o0, 0, 0, 0); \
                o1 = __builtin_amdgcn_mfma_f32_16x16x32_bf16(cat4(y0, y1), bS, o1, 0, 0, 0); \
            } \
            { \
                LAS unsigned char* vq = B + GL_V + (8 * hh + q4) * GL_ROW + (16 * w + 4 * p4) * 2; \
                const bf16x8 vN = cat4(lds_tr(vq), lds_tr(vq + 4 * GL_ROW)); \
_Pragma("unroll") \
                for (int i = 0; i < 8; ++i) { \
                    LAS unsigned char* kp = B + GL_KD + (8 * hh + q4) * GL_ROW + (16 * i + 4 * p4) * 2; \
                    const bf16x8 kA = cat4(lds_tr(kp), lds_tr(kp + 4 * GL_ROW)); \
                    S[i] = __builtin_amdgcn_mfma_f32_16x16x32_bf16(kA, vN, S[i], 0, 0, 0) * dch[i]; \
                } \
            } \
_Pragma("unroll") \
            for (int r = 0; r < 4; ++r) { \
                *(LAS float*)(OT + (4 * hh + r) * GL_OTROW + (16 * w + c16) * 4) = o0[r]; \
                *(LAS float*)(OT + (16 + 4 * hh + r) * GL_OTROW + (16 * w + c16) * 4) = o1[r]; \
            } \
            { \
                LAS unsigned char* dst = lds + ((ck + 1) & 1) * GL_BUF + srow * GL_ROW + sch * 16; \
                *(LAS u32x4*)(dst + GL_QS) = WRSET##a; *(LAS u32x4*)(dst + GL_KD) = WRSET##b; *(LAS u32x4*)(dst + GL_V) = WRSET##d; *(LAS u32x4*)(dst + GL_G) = WRSET##e; \
                if (tid < 32) *(LAS f32x4*)(lds + ((ck + 1) & 1) * GL_BUF + GL_DCH + tid * 16) = WRSET##f; \
            } \
            __syncthreads(); \
        } while (0)
__device__ __forceinline__ void p_gla(const Ctx& C0) {
    const Ctx C = C0;
    unsigned char* const ws_ = wsp(C); float* const out_ = outp(C);
    const bf16_t* QS = (const bf16_t*)(ws_ + WS_QS); const bf16_t* KD = (const bf16_t*)(ws_ + WS_KD);
    const bf16_t* V = (const bf16_t*)(ws_ + WS_V); const bf16_t* Gt = (const bf16_t*)(ws_ + WS_G); const float* DCH = (const float*)(ws_ + WS_DCH);
    bf16_t* O = (bf16_t*)(ws_ + WS_O); const float* gn_g = inp(C, 12); const float* S0in = inp(C, 2);
    LAS unsigned char* lds = C.lds;
    const int tid = C.tid, lane = C.lane, w = C.wave, c16 = lane & 15, hh = lane >> 4, q4 = (lane & 15) >> 2, p4 = lane & 3;
    const int srow = tid >> 4, sch = tid & 15;
    const unsigned soff = (unsigned)(srow * D + sch * 8) * 2u;
    const unsigned ooff = (unsigned)((4 * w + hh) * D + c16 * 8) * 2u;
    const unsigned stoff = (unsigned)(4 * hh * 128 + 16 * w + c16) * 4u;
    const int NPI = 128, NSI = 1024, half = C.G >= 256 ? 128 : 0;
    for (int it = 0;; ++it) {
        int item;
        if (half) { if (C.bid < half) { if (it > GLA_PROMPT_REPS - 1) break; item = C.bid; } else { item = NPI + (C.bid - half) + it * (C.G - half); if (item >= NPI + NSI) break; } }
        else { item = C.bid + it * C.G; if (item >= NPI + NSI) break; }
        int rbase, h, nck; float* Sout; const float* Sin = nullptr;
        if (item < NPI) { const int b = item >> 5; h = item & 31; rbase = b * 4096; nck = 128; Sout = out_ + OUT_SP + (size_t)item * 16384; }
        else { const int si = item - NPI, s = si >> 5; h = si & 31; rbase = MP + s * 32; nck = 1; Sout = out_ + OUT_SS + (size_t)si * 16384; Sin = S0in + (size_t)si * 16384; }
        const int cb = h * 128;
        f32x4 S[8];
#pragma unroll
        for (int i = 0; i < 8; ++i) {
            if (Sin) {
#pragma unroll
                for (int r = 0; r < 4; ++r) S[i][r] = ldo<float>(Sin + (16 * i + r) * 128, stoff);
            } else S[i] = (f32x4){0.f, 0.f, 0.f, 0.f};
        }
        __syncthreads();
        {
            const size_t u0 = (size_t)rbase * D + cb;
            const u32x4 a = ldo<u32x4>(QS + u0, soff), b = ldo<u32x4>(KD + u0, soff), d = ldo<u32x4>(V + u0, soff), e = ldo<u32x4>(Gt + u0, soff);
            LAS unsigned char* dst = lds + srow * GL_ROW + sch * 16;
            *(LAS u32x4*)(dst + GL_QS) = a; *(LAS u32x4*)(dst + GL_KD) = b; *(LAS u32x4*)(dst + GL_V) = d; *(LAS u32x4*)(dst + GL_G) = e;
            if (tid < 32) *(LAS f32x4*)(lds + GL_DCH + tid * 16) = ldo<f32x4>(DCH + (size_t)(rbase >> 5) * D + cb, (unsigned)tid * 16u);
        }
        __syncthreads();
        const f32x4 g0 = ldo<f32x4>(gn_g + cb, (unsigned)c16 * 32u), g1 = ldo<f32x4>(gn_g + cb, (unsigned)c16 * 32u + 16u);
        u32x4 RAa, RAb, RAd, RAe, RBa, RBb, RBd, RBe; f32x4 RAf = {0.f, 0.f, 0.f, 0.f}, RBf = RAf;
        { const int c1 = nck > 1 ? 1 : 0; const size_t u1 = (size_t)(rbase + 32 * c1) * D + cb; RAa = ldo<u32x4>(QS + u1, soff); RAb = ldo<u32x4>(KD + u1, soff); RAd = ldo<u32x4>(V + u1, soff); RAe = ldo<u32x4>(Gt + u1, soff);
            if (w == 0) RAf = ldo<f32x4>(DCH + (size_t)((rbase >> 5) + c1) * D + cb, (unsigned)(tid & 31) * 16u); }
        u32x4 gprev = {0u, 0u, 0u, 0u};
        for (int ck2 = 0; ck2 < nck; ck2 += 2) {
            GLA_STEP(ck2, RA, RB);
            if (ck2 + 1 < nck) GLA_STEP(ck2 + 1, RB, RA);
        }
        GLA_NORM(nck - 1, gprev);
#pragma unroll
        for (int i = 0; i < 8; ++i)
#pragma unroll
            for (int r = 0; r < 4; ++r) sto<float>(Sout + (16 * i + r) * 128, stoff, S[i][r]);
    }
    __syncthreads();
    conv_queue(C, 5, CV_S4B, CV_S5);
}
#define PHASE_FN __device__ __forceinline__ void
PHASE_FN ph_prologue() { const Ctx C = make_ctx(); p0_prologue(C); }
PHASE_FN ph_gemm_ain() {
    const Ctx C = make_ctx(); unsigned char* const ws_ = wsp(C);
    pg8::Gemm g{(const bf16_t*)(ws_ + WS_XB), (const bf16_t*)(ws_ + WS_W_AIN), M, NAIN, D}; const QueueOrder S = make_queue(C, ws_, 0, M, NAIN);
    EpiGelu E{(bf16_t*)(ws_ + WS_Z), (float*)(ws_ + WS_STAT)};
    pg8::gemm_phase<EpiGelu, QueueOrder, true, true>(C.lds, g, S, E);
    conv_queue(C, 1, CV_S1, CV_S2);
}
#ifdef PROBE_NULL
PHASE_FN ph_probe() {
    const Ctx C = make_ctx(); unsigned char* const ws_ = wsp(C); float* const out_ = outp(C);
    pg8::Gemm g{(const bf16_t*)(ws_ + WS_XB), (const bf16_t*)(ws_ + WS_W_UP0), M, NUP, D}; const QueueOrder S = make_queue(C, ws_, 4 + L, M, NUP);
#if PROBE_NULL == 1
    EpiNull E{(float*)(ws_ + WS_SLAB)};
    pg8::gemm_phase<EpiNull, pg8::StaticOrder, true, true>(C.lds, g, S, E);
#else
    EpiUpConv E{(bf16_t*)(ws_ + WS_HG), (bf16_t*)(ws_ + WS_SIDE), out_ + OUT_CP, out_ + OUT_CS, inp(C, 15), inp(C, 16)};
    pg8::gemm_phase<EpiUpConv, pg8::StaticOrder, true, true>(C.lds, g, S, E);
#endif
}
#endif
PHASE_FN ph_rowstat() { const Ctx C = make_ctx(); p_rowstat(C); }
PHASE_FN ph_spatial() { const Ctx C = make_ctx(); p_spatial(C); }
PHASE_FN ph_gemm_bin() {
    const Ctx C = make_ctx(); unsigned char* const ws_ = wsp(C);
    pg8::Gemm g{(const bf16_t*)(ws_ + WS_XB), (const bf16_t*)(ws_ + WS_W_BIN), M, NBIN, D}; const QueueOrder S = make_queue(C, ws_, 1, M, NBIN);
    EpiBin E{ws_};
    pg8::gemm_phase<EpiBin, QueueOrder, true, true>(C.lds, g, S, E);
}
PHASE_FN ph_gla() { const Ctx C = make_ctx(); p_gla(C); }
template <int L> PHASE_FN ph_gemm_out() {
    const Ctx C = make_ctx(); unsigned char* const ws_ = wsp(C);
    pg8::Gemm g{(const bf16_t*)(ws_ + (L == 0 ? WS_GATED : WS_O)), (const bf16_t*)(ws_ + (L == 0 ? WS_W_AOUT : WS_W_BOUT)), M, D, D}; const QueueOrder S = make_queue(C, ws_, 2 + L, M, D);
    EpiRes<L == 0 ? 0 : 1> E{L == 0 ? inp(C, 0) : nullptr, L == 0 ? inp(C, 1) : nullptr, (const f32x2*)(ws_ + WS_RS2), L == 0 ? nullptr : inp(C, 20), L == 0 ? nullptr : inp(C, 21), (bf16_t*)(ws_ + WS_H32), (float*)(ws_ + WS_STAT)};
    pg8::gemm_phase<EpiRes<L == 0 ? 0 : 1>, QueueOrder, true, true>(C.lds, g, S, E);
    conv_queue(C, L == 0 ? 2 : 6, L == 0 ? CV_S2 : CV_S5, L == 0 ? CV_S3 : CV_END);
}
template <int L> PHASE_FN ph_ln1() { const Ctx C = make_ctx(); unsigned char* const ws_ = wsp(C); p_ln_apply(C, inp(C, 18) + (size_t)L * D, inp(C, 19) + (size_t)L * D, (bf16_t*)(ws_ + WS_XB), nullptr); }
template <int L> PHASE_FN ph_gemm_up() {
    const Ctx C = make_ctx(); unsigned char* const ws_ = wsp(C); float* const out_ = outp(C);
    pg8::Gemm g{(const bf16_t*)(ws_ + WS_XB), (const bf16_t*)(ws_ + (L == 0 ? WS_W_UP0 : WS_W_UP1)), M, NUP, D}; const QueueOrder S = make_queue(C, ws_, 4 + L, M, NUP);
    EpiUpConv E{(bf16_t*)(ws_ + WS_HG), (bf16_t*)(ws_ + WS_SIDE), out_ + OUT_CP + (size_t)L * 4 * 2 * DFF, out_ + OUT_CS + (size_t)L * 32 * 2 * DFF, inp(C, 15) + (size_t)L * 3 * DFF, inp(C, 16) + (size_t)L * DFF};
    pg8::gemm_phase<EpiUpConv, QueueOrder, true, true>(C.lds, g, S, E);
    if (L == 0) conv_queue(C, 3, CV_S3, CV_S4);
}
template <int L> PHASE_FN ph_conv() { const Ctx C = make_ctx(); p_convfix(C, L); }
template <int L> PHASE_FN ph_gemm_dn() {
    const Ctx C = make_ctx(); unsigned char* const ws_ = wsp(C);
    pg8::Gemm g{(const bf16_t*)(ws_ + WS_HG), (const bf16_t*)(ws_ + (L == 0 ? WS_W_DN0 : WS_W_DN1)), M, D, DFF}; QueueOrder S = make_queue(C, ws_, 6 + L, M, D);
    EpiRes<1> E{nullptr, nullptr, (const f32x2*)(ws_ + WS_RS2), inp(C, 18) + (size_t)L * D, inp(C, 19) + (size_t)L * D, (bf16_t*)(ws_ + WS_H32), (float*)(ws_ + WS_STAT)};
    if (L == 1 && C.G == 256) {
        S.b.cap = 4 * 256;
        pg8::gemm_phase<EpiRes<1>, QueueOrder, true, true>(C.lds, g, S, E);
        const int kq = C.bid & 3, kt0 = kq == 0 ? 0 : (kq == 1 ? 44 : (kq == 2 ? 88 : 130)), nkt = kq < 2 ? 44 : 42;
        pg8::Gemm g2{g.A + kt0 * 64, g.Bt + kt0 * 64, M, D, nkt * 64, DFF};
        SplitOrder S2; S2.b.init(M, D, C.G, 0); S2.L = 4 * 256 + (C.bid >> 2);
        EpiPartial E2{(float*)(ws_ + WS_SLAB) + (size_t)C.bid * 65536};
        pg8::gemm_phase<EpiPartial, SplitOrder, true, true>(C.lds, g2, S2, E2);
    } else {
        pg8::gemm_phase<EpiRes<1>, QueueOrder, true, true>(C.lds, g, S, E);
        if (L == 0) conv_queue(C, 4, CV_S4, CV_S4B);
    }
}
PHASE_FN ph_dnfix() {
    const Ctx C = make_ctx(); unsigned char* const ws_ = wsp(C);
    if (C.G != 256) return;
    EpiRes<1> E{nullptr, nullptr, (const f32x2*)(ws_ + WS_RS2), inp(C, 18) + (size_t)D, inp(C, 19) + (size_t)D, (bf16_t*)(ws_ + WS_H32), (float*)(ws_ + WS_STAT)};
    pg8::StaticOrder S; S.init(M, D, C.G, 0);
    const int wr = C.wave >> 2, wc = C.wave & 3, fr = C.lane & 15, fq = C.lane >> 4;
    const unsigned t = (unsigned)(((wr * 4 + wc) * 4 + fq) * 16 + fr);
    for (int idx = C.bid >> 1; idx < 64 && C.bid < 128; idx += 64) {
        pg8::Unit u; if (!S.unit_of(4 * 256 + idx, u)) break;
        const float* slab = (const float*)(ws_ + WS_SLAB) + (size_t)idx * 4 * 65536;
        pg8::f32x4 acc[2][2][4][2];
#define DNFIX_HALF(AI) do { \
            _Pragma("unroll") for (int bj = 0; bj < 2; ++bj) _Pragma("unroll") for (int m = 0; m < 4; ++m) { \
                  \
                const unsigned o0 = ((unsigned)(((((AI) * 2 + bj) * 4 + m) * 2 + 0) * 512) + t) * 16u, o1 = o0 + 512u * 16u; \
                const pg8::f32x4 a0 = ldo<pg8::f32x4>(slab, o0), a1 = ldo<pg8::f32x4>(slab + 65536, o0), a2 = ldo<pg8::f32x4>(slab + 2 * 65536, o0), a3 = ldo<pg8::f32x4>(slab + 3 * 65536, o0); \
                const pg8::f32x4 b0 = ldo<pg8::f32x4>(slab, o1), b1 = ldo<pg8::f32x4>(slab + 65536, o1), b2 = ldo<pg8::f32x4>(slab + 2 * 65536, o1), b3 = ldo<pg8::f32x4>(slab + 3 * 65536, o1); \
                acc[AI][bj][m][0] = (a0 + a1) + (a2 + a3); acc[AI][bj][m][1] = (b0 + b1) + (b2 + b3); } \
            E.run<AI, AI + 1>(acc, u, wr, wc, fr, fq); } while (0)
        if ((C.bid & 1) == 0) DNFIX_HALF(0); else DNFIX_HALF(1);
#undef DNFIX_HALF
    }
}
template <int L> PHASE_FN ph_ln2() {
    const Ctx C = make_ctx(); unsigned char* const ws_ = wsp(C);
    p_ln_apply(C, inp(C, 20) + (size_t)L * D, inp(C, 21) + (size_t)L * D, L == 0 ? (bf16_t*)(ws_ + WS_XB) : nullptr, L == 0 ? nullptr : outp(C) + OUT_Y);
}
PHASE_FN ph_barrier() {
    const Ctx C = make_ctx();
    XcdBarrier b; b.bar = (unsigned*)(wsp(C) + WS_CTL) + CW_BAR; b.x = xb_xcc_id(); b.st = (volatile LAS unsigned*)(C.lds + MISC_OFF) + 8;
    xcd_barrier(b);
}

struct Args { const float* in[22]; float* out; unsigned char* ws; int ph_lo, ph_hi; };
static_assert(sizeof(Args) == 22 * 8 + 8 + 8 + 8, "Args has no padding");

__global__ void __launch_bounds__(512, 2) fwd_kernel(Args args) {
    LAS unsigned char* lds = (LAS unsigned char*)lds_raw;
    const int tid = threadIdx.x;
    volatile LAS unsigned* MISC = (volatile LAS unsigned*)(lds + MISC_OFF);
    if (tid < 64) MISC[tid] = 0u;
    if (tid == 64) {
        volatile LAS unsigned long long* pt = (volatile LAS unsigned long long*)(lds + PTR_OFF);
#pragma unroll
        for (int i = 0; i < 22; ++i) pt[i] = (unsigned long long)args.in[i];
        pt[22] = (unsigned long long)args.out; pt[23] = (unsigned long long)args.ws;
    }
    __syncthreads();
    if (N_LAUNCHES == 1) (void)xcd_barrier_post((unsigned*)(args.ws + WS_CTL) + CW_BAR, MISC + 8);
#ifndef REPS
#define REPS {1,1,1,1,1,1,1,1,1,1,1,1,1,1,1,1,1,1,1,1}
#endif
    constexpr int REPS_[NPHASE] = REPS;
    const int lo = args.ph_lo, hi = args.ph_hi;
#define IN(k) (lo <= (k) && (k) < hi)
#define SEAM(k) do { if (IN(k) && IN((k) + 1)) ph_barrier(); } while (0)
    if (IN(0)) { for (int r_ = 0; r_ < REPS_[0]; ++r_) ph_prologue(); }
    SEAM(0);
    if (IN(1)) { for (int r_ = 0; r_ < REPS_[1]; ++r_) ph_gemm_ain(); }

    SEAM(1);
    if (IN(2)) { for (int r_ = 0; r_ < REPS_[2]; ++r_) ph_rowstat(); }
    SEAM(2);
    if (IN(3)) { for (int r_ = 0; r_ < REPS_[3]; ++r_) ph_spatial(); }
    SEAM(3);
    if (IN(4)) { for (int r_ = 0; r_ < REPS_[4]; ++r_) ph_gemm_out<0>(); }
    SEAM(4);
    if (IN(5)) { for (int r_ = 0; r_ < REPS_[5]; ++r_) ph_ln1<0>(); }
    SEAM(5);
    if (IN(6)) { for (int r_ = 0; r_ < REPS_[6]; ++r_) ph_gemm_up<0>(); }
#ifdef PROBE_NULL
    if (IN(6)) { ph_barrier(); ph_probe(); }
#endif
    SEAM(6);
    if (IN(7)) { for (int r_ = 0; r_ < REPS_[7]; ++r_) ph_conv<0>(); }
    SEAM(7);
    if (IN(8)) { for (int r_ = 0; r_ < REPS_[8]; ++r_) ph_gemm_dn<0>(); }
    SEAM(8);
    if (IN(9)) { for (int r_ = 0; r_ < REPS_[9]; ++r_) ph_ln2<0>(); }
    SEAM(9);
    if (IN(10)) { for (int r_ = 0; r_ < REPS_[10]; ++r_) ph_gemm_bin(); }
    SEAM(10);
    if (IN(12)) { for (int r_ = 0; r_ < REPS_[12]; ++r_) ph_gla(); }
    SEAM(12);
    if (IN(13)) { for (int r_ = 0; r_ < REPS_[13]; ++r_) ph_gemm_out<1>(); }
    SEAM(13);
    if (IN(14)) { for (int r_ = 0; r_ < REPS_[14]; ++r_) ph_ln1<1>(); }
    SEAM(14);
    if (IN(15)) { for (int r_ = 0; r_ < REPS_[15]; ++r_) ph_gemm_up<1>(); }
    SEAM(15);
    if (IN(16)) { for (int r_ = 0; r_ < REPS_[16]; ++r_) ph_conv<1>(); }
    SEAM(16);
    if (IN(17)) { for (int r_ = 0; r_ < REPS_[17]; ++r_) ph_gemm_dn<1>(); }
    SEAM(17);
    if (IN(18)) { for (int r_ = 0; r_ < REPS_[18]; ++r_) ph_dnfix(); }
    SEAM(18);
    if (IN(19)) { for (int r_ = 0; r_ < REPS_[19]; ++r_) ph_ln2<1>(); }
#undef IN
#undef SEAM
}

#ifdef DBG_STOP
__global__ void dbg_fold(const unsigned* src, size_t n_words, float* out, size_t n_out) {
    for (size_t j = (size_t)blockIdx.x * blockDim.x + threadIdx.x; j < n_out; j += (size_t)gridDim.x * blockDim.x) {
        unsigned acc = 0u; for (size_t i = j; i < n_words; i += n_out) acc ^= src[i];
        acc ^= acc >> 16; acc ^= acc >> 8; out[j] = (float)(acc & 0xffu);
    }
}
#endif
extern "C" void kernel_launch(void* const* d_in, const int* in_sizes, int n_in, void* d_out, int out_size, void* d_ws, size_t ws_size, hipStream_t stream) {
    static int grid = 0;
    if (grid == 0) {
        if (n_in != 22 || (size_t)out_size != OUT_END || ws_size < WS_END) { fprintf(stderr, "kernel_launch: unexpected shapes (n_in %d, out %d, ws %zu)\n", n_in, out_size, ws_size); grid = -1; return; }
        int dev = 0, cus = 0;
        if (hipGetDevice(&dev) != hipSuccess || hipDeviceGetAttribute(&cus, hipDeviceAttributeMultiprocessorCount, dev) != hipSuccess) { grid = -1; return; }
        if (hipFuncSetAttribute((const void*)fwd_kernel, hipFuncAttributeMaxDynamicSharedMemorySize, LDS_BYTES) != hipSuccess) { fprintf(stderr, "kernel_launch: hipFuncSetAttribute failed\n"); grid = -1; return; }
        int per_cu = 0;
        if (hipOccupancyMaxActiveBlocksPerMultiprocessor(&per_cu, (const void*)fwd_kernel, 512, LDS_BYTES) != hipSuccess || per_cu < 1) fprintf(stderr, "kernel_launch: occupancy query says %d\n", per_cu);
        (void)hipGetLastError();
        grid = cus;
    }
    if (grid < 0) return;
    (void)hipMemsetAsync((char*)d_ws + WS_CTL, 0, CTL_BYTES, stream);
    Args a{};
    for (int i = 0; i < 22; ++i) a.in[i] = (const float*)d_in[i];
    a.out = (float*)d_out; a.ws = (unsigned char*)d_ws;
    if (N_LAUNCHES == 1) { a.ph_lo = 0; a.ph_hi = NPHASE; hipLaunchKernelGGL(fwd_kernel, dim3(grid), dim3(512), LDS_BYTES, stream, a); }
    else for (int p = 0; p < NPHASE; ++p) {
#ifdef DBG_STOP
        if (p > DBG_STOP) break;
#endif
        a.ph_lo = p; a.ph_hi = p + 1; hipLaunchKernelGGL(fwd_kernel, dim3(grid), dim3(512), LDS_BYTES, stream, a); }
#ifdef DBG_STOP
    hipLaunchKernelGGL(dbg_fold, dim3(2048), dim3(256), 0, stream, (const unsigned*)((const char*)d_ws + (size_t)(DBG_OFF)), (size_t)(DBG_BYTES) / 4, (float*)d_out, (size_t)out_size);
#endif
}
```

```cpp
#include <hip/hip_runtime.h>
#include <cstdio>
#include <cstdint>
#define LAS __attribute__((address_space(3)))
#define GAS __attribute__((address_space(1)))
#define N_LAUNCHES 1

namespace pg8 {
#define PG8_LAS __attribute__((address_space(3)))
typedef unsigned short bf16_t;
typedef short bf16x8 __attribute__((ext_vector_type(8)));
typedef float f32x4 __attribute__((ext_vector_type(4)));
typedef unsigned u32x4 __attribute__((ext_vector_type(4)));
constexpr int BM = 256, BK = 64, HALF = 128, HTB = HALF * BK * 2  , STAGE_BYTES = 8 * HTB, NXCD = 8, WGM = 8;

__host__ __device__ __forceinline__ int lds_byte(int r, int c) { const int st = (r >> 4) * 2 + (c >> 5), rr = r & 15, cc = c & 31, ob = rr * 64 + cc * 2; return st * 1024 + (ob ^ (((ob >> 9) & 1) << 5)); }
__host__ __device__ __forceinline__ void stage_rc(int b, int& R, int& C) { const int st = b / 1024, sb = b % 1024, swz = sb ^ (((sb >> 9) & 1) << 5); R = (st >> 1) * 16 + swz / 64; C = (st & 1) * 32 + (swz % 64) / 2; }
__host__ __device__ __forceinline__ int perm32(int rho) { const int n = rho >> 4, i = rho & 15; return 8 * (i >> 2) + 4 * n + (i & 3); }

struct Unit { int pm, pn; };
struct Gemm { const bf16_t* A; const bf16_t* Bt; int M, N, K, P; };

struct StaticOrder {
    int nM, nN, nwg, G, c, cap;
    __host__ __device__ void init(int M, int N, int G_, int c_) { nM = M / BM; nN = N / BM; nwg = nM * nN; G = G_; c = c_; cap = nwg; }
    __host__ __device__ bool next(int i, Unit& u) const { return unit_of((long)i * G + c, u); }
    __host__ __device__ bool unit_of(long L, Unit& u) const {
        if (L >= cap) return false;
        int wgid = (int)L;
        { const int nig0 = WGM * nN, rem = nwg - NXCD * nig0;
          if (nM / WGM == NXCD && rem >= 0 && rem % NXCD == 0) {
              const int x = wgid % NXCD, t = wgid / NXCD, rem8 = rem / NXCD;
              wgid = t < nig0 ? x * nig0 + t : NXCD * nig0 + x * rem8 + (t - nig0);
          } else { const int q = nwg / NXCD, r = nwg % NXCD, xcd = wgid % NXCD, off = wgid / NXCD; wgid = (xcd < r ? xcd * (q + 1) : r * (q + 1) + (xcd - r) * q) + off; } }
        const int nig = WGM * nN, gid = wgid / nig, fm = gid * WGM, gsz = (nM - fm) < WGM ? (nM - fm) : WGM;
        u.pm = fm + ((wgid % nig) % gsz); u.pn = (wgid % nig) / gsz; return true;
    }
    __device__ __forceinline__ void a_ready(const Unit&) const {}
    __device__ __forceinline__ void done(const Unit&) const {}
    __device__ __forceinline__ int issue(int, int, int) const { return 0; }
    __device__ __forceinline__ bool resolve(int, int i, Unit& u, int, int) const { return next(i, u); }
};

__device__ __forceinline__ unsigned cvt_pk_bf16(float lo, float hi) { unsigned r; asm volatile("v_cvt_pk_bf16_f32 %0, %1, %2" : "=v"(r) : "v"(lo), "v"(hi)); return r; }
template <class Epi, class Sched, bool ALIGN_EPI = false, bool SP2 = false>
__device__ __forceinline__ void gemm_phase(PG8_LAS unsigned char* lds, const Gemm g, const Sched& S, const Epi& E) {
    int tid_ = threadIdx.x; asm volatile("" : "+v"(tid_));
    const int tid = tid_, wid = __builtin_amdgcn_readfirstlane(tid >> 6), lane = tid & 63, wr = wid >> 2, wc = wid & 3, fr = lane & 15, fq = lane >> 4;
    const int nt = g.K / BK, K = g.P ? g.P : g.K;
    unsigned voffA[2], voffB[2];
#pragma unroll
    for (int i = 0; i < 2; ++i) { int R, C; stage_rc(tid * 16 + i * 8192, R, C); const int Rb = Epi::PERM ? ((R & ~31) + perm32(R & 31)) : R;
        voffA[i] = (unsigned)(R * K + C) * 2u; voffB[i] = (unsigned)(Rb * K + C) * 2u; }
    const size_t kstep = (size_t)(BK * 2);
    const size_t hstep = (size_t)HALF * K * 2;
    const size_t tstep = 2 * hstep;
    const unsigned ldsw = (unsigned)wid * 1024u;
    const int aoff = lds_byte(wr * 64 + fr, fq * 8), boff = lds_byte(wc * 32 + fr, fq * 8);
#define PG8_SA(b, h) (((b) * 2 + (h)) * HTB)
#define PG8_SB(b, h) ((4 + (b) * 2 + (h)) * HTB)
#define PG8_STAGE(bufoff, gbase, voff) do { _Pragma("unroll") for (int _i = 0; _i < 2; ++_i) \
        __builtin_amdgcn_global_load_lds((const unsigned*)((const char*)(gbase) + (voff)[_i]), (PG8_LAS unsigned*)(lds + (bufoff) + ldsw + _i * 8192), 16, 0, 0); } while (0)
#define PG8_LDA(dst, b, h) do { _Pragma("unroll") for (int m = 0; m < 4; ++m) _Pragma("unroll") for (int k = 0; k < 2; ++k) dst[m][k] = *(const PG8_LAS bf16x8*)(lds + PG8_SA(b, h) + aoff + m * 2048 + k * 1024); } while (0)
#define PG8_LDB(dst, b, h) do { _Pragma("unroll") for (int n = 0; n < 2; ++n) _Pragma("unroll") for (int k = 0; k < 2; ++k) dst[n][k] = *(const PG8_LAS bf16x8*)(lds + PG8_SB(b, h) + boff + n * 2048 + k * 1024); } while (0)
#define PG8_MMA(ai, bj, At, Bt) do { __builtin_amdgcn_s_setprio(1); _Pragma("unroll") for (int m = 0; m < 4; ++m) _Pragma("unroll") for (int n = 0; n < 2; ++n) _Pragma("unroll") for (int k = 0; k < 2; ++k) \
        acc[ai][bj][m][n] = __builtin_amdgcn_mfma_f32_16x16x32_bf16(Bt[n][k], At[m][k], acc[ai][bj][m][n], 0, 0, 0); __builtin_amdgcn_s_setprio(0); } while (0)
#define PG8_WAIT_V(n) asm volatile("s_waitcnt vmcnt(" #n ")" ::: "memory")
#define PG8_WAIT_L(n) asm volatile("s_waitcnt lgkmcnt(" #n ")" ::: "memory")
#define PG8_BAR __builtin_amdgcn_s_barrier()
#define PG8_SCHED __builtin_amdgcn_sched_barrier(0)
    Unit cur, nxt; int ui = 0;
    { const int tk0 = S.issue(0, wid, lane); if (!S.resolve(tk0, 0, cur, wid, lane)) return; }
    f32x4 acc[2][2][4][2];
#pragma unroll
    for (int a = 0; a < 2; ++a)
#pragma unroll
        for (int b = 0; b < 2; ++b)
#pragma unroll
            for (int m = 0; m < 4; ++m)
#pragma unroll
                for (int n = 0; n < 2; ++n) acc[a][b][m][n] = (f32x4){0.f, 0.f, 0.f, 0.f};
    bf16x8 At[4][2], B0[2][2], B1[2][2];
    const char* cA = (const char*)g.A + (size_t)cur.pm * tstep; const char* cB = (const char*)g.Bt + (size_t)cur.pn * tstep;
    S.a_ready(cur);
    if constexpr (SP2) {
        PG8_STAGE(PG8_SB(0, 0), cB, voffB); PG8_STAGE(PG8_SB(0, 1), cB + hstep, voffB); PG8_STAGE(PG8_SA(0, 0), cA, voffA); PG8_STAGE(PG8_SA(0, 1), cA + hstep, voffA);
        if (wr == 1) PG8_BAR;
        PG8_WAIT_V(2); PG8_BAR;
        PG8_STAGE(PG8_SB(1, 0), cB + kstep, voffB); PG8_STAGE(PG8_SA(1, 0), cA + kstep, voffA); PG8_STAGE(PG8_SB(1, 1), cB + hstep + kstep, voffB);
        PG8_WAIT_V(6); PG8_BAR;
    } else {
        PG8_STAGE(PG8_SB(0, 0), cB, voffB); PG8_STAGE(PG8_SA(0, 0), cA, voffA); PG8_STAGE(PG8_SB(0, 1), cB + hstep, voffB); PG8_STAGE(PG8_SA(0, 1), cA + hstep, voffA);
        if (wr == 1) PG8_BAR;
        PG8_WAIT_V(4); PG8_BAR;
        PG8_STAGE(PG8_SB(1, 0), cB + kstep, voffB); PG8_STAGE(PG8_SA(1, 0), cA + kstep, voffA); PG8_STAGE(PG8_SB(1, 1), cB + hstep + kstep, voffB);
        PG8_WAIT_V(6); PG8_BAR;
    }
    for (;;) {
        const int tk = S.issue(ui + 1, wid, lane);
        bool has_next = false;
        const char* nA = cA; const char* nB = cB;
        for (int t = 0; t < nt; t += 2) {
            const bool last = (t == nt - 2);
            if (last) { has_next = S.resolve(tk, ui + 1, nxt, wid, lane); if (has_next) { nA = (const char*)g.A + (size_t)nxt.pm * tstep; nB = (const char*)g.Bt + (size_t)nxt.pn * tstep; } }
            const char* a1 = cA + (size_t)(t + 1) * kstep;
            const char* a2 = last ? nA : cA + (size_t)(t + 2) * kstep; const char* b2 = last ? nB : cB + (size_t)(t + 2) * kstep;
            const char* a3 = a2 + kstep; const char* b3 = b2 + kstep;
            if (last && has_next) S.a_ready(nxt);
            if constexpr (SP2) {
            PG8_LDB(B0, 0, 0); PG8_LDB(B1, 0, 1); PG8_SCHED; PG8_LDA(At, 0, 0); PG8_STAGE(PG8_SA(1, 1), a1 + hstep, voffA);
            PG8_WAIT_V(8); PG8_WAIT_L(0); PG8_BAR; PG8_MMA(0, 0, At, B0); PG8_MMA(0, 1, At, B1); PG8_BAR; PG8_SCHED;
            PG8_LDA(At, 0, 1); PG8_STAGE(PG8_SB(0, 0), b2, voffB); PG8_STAGE(PG8_SB(0, 1), b2 + hstep, voffB); PG8_STAGE(PG8_SA(0, 0), a2, voffA);
            PG8_WAIT_V(8); PG8_WAIT_L(0); PG8_BAR; PG8_MMA(1, 0, At, B0); PG8_MMA(1, 1, At, B1); PG8_BAR; PG8_SCHED;
            PG8_LDB(B0, 1, 0); PG8_LDB(B1, 1, 1); PG8_SCHED; PG8_LDA(At, 1, 0); PG8_STAGE(PG8_SA(0, 1), a2 + hstep, voffA);
            PG8_WAIT_V(8); PG8_WAIT_L(0); PG8_BAR; PG8_MMA(0, 0, At, B0); PG8_MMA(0, 1, At, B1); PG8_BAR; PG8_SCHED;
            PG8_LDA(At, 1, 1); PG8_STAGE(PG8_SB(1, 0), b3, voffB); PG8_STAGE(PG8_SB(1, 1), b3 + hstep, voffB); PG8_STAGE(PG8_SA(1, 0), a3, voffA);
            PG8_WAIT_V(8); PG8_WAIT_L(0); PG8_BAR; PG8_MMA(1, 0, At, B0); PG8_MMA(1, 1, At, B1); PG8_BAR; PG8_SCHED;
            } else {
            PG8_LDB(B0, 0, 0); PG8_SCHED; PG8_LDA(At, 0, 0); PG8_STAGE(PG8_SA(1, 1), a1 + hstep, voffA);
            PG8_WAIT_L(8); PG8_BAR; PG8_WAIT_L(0); PG8_MMA(0, 0, At, B0); PG8_BAR; PG8_SCHED;
            PG8_LDB(B1, 0, 1); PG8_STAGE(PG8_SB(0, 0), b2, voffB);
            PG8_BAR; PG8_WAIT_L(0); PG8_MMA(0, 1, At, B1); PG8_BAR;
            PG8_LDA(At, 0, 1); PG8_STAGE(PG8_SA(0, 0), a2, voffA);
            PG8_BAR; PG8_WAIT_L(0); PG8_MMA(1, 0, At, B0); PG8_BAR; PG8_SCHED;
            PG8_STAGE(PG8_SB(0, 1), b2 + hstep, voffB);
            PG8_WAIT_V(6); PG8_BAR; PG8_MMA(1, 1, At, B1); PG8_BAR;
            PG8_LDB(B0, 1, 0); PG8_SCHED; PG8_LDA(At, 1, 0); PG8_STAGE(PG8_SA(0, 1), a2 + hstep, voffA);
            PG8_WAIT_L(8); PG8_BAR; PG8_WAIT_L(0); PG8_MMA(0, 0, At, B0); PG8_BAR; PG8_SCHED;
            PG8_LDB(B1, 1, 1); PG8_STAGE(PG8_SB(1, 0), b3, voffB);
            PG8_BAR; PG8_WAIT_L(0); PG8_MMA(0, 1, At, B1); PG8_BAR;
            PG8_LDA(At, 1, 1); PG8_STAGE(PG8_SA(1, 0), a3, voffA);
            PG8_BAR; PG8_WAIT_L(0); PG8_MMA(1, 0, At, B0); PG8_BAR; PG8_SCHED;
            PG8_STAGE(PG8_SB(1, 1), b3 + hstep, voffB);
            PG8_WAIT_V(6); PG8_BAR; PG8_MMA(1, 1, At, B1); PG8_BAR;
            }
        }
        if constexpr (ALIGN_EPI) { if (wr == 0) PG8_BAR; }
        if constexpr (!Epi::AFTER_DRAIN) { E(acc, cur, wr, wc, fr, fq); S.done(cur); }
        if (!has_next) break;
#pragma unroll
        for (int a = 0; a < 2; ++a)
#pragma unroll
            for (int b = 0; b < 2; ++b)
#pragma unroll
                for (int m = 0; m < 4; ++m)
#pragma unroll
                    for (int n = 0; n < 2; ++n) acc[a][b][m][n] = (f32x4){0.f, 0.f, 0.f, 0.f};
        cur = nxt; cA = nA; cB = nB; ++ui;
        if constexpr (ALIGN_EPI) { if (wr == 1) PG8_BAR; }
    }
    PG8_WAIT_V(0);
    if constexpr (!ALIGN_EPI) { if (wr == 0) PG8_BAR; }
    PG8_BAR;
    if constexpr (Epi::AFTER_DRAIN) { E.fused(acc, cur, wr, wc, fr, fq, lds, wid, lane); S.done(cur); }
#undef PG8_SA
#undef PG8_SB
#undef PG8_STAGE
#undef PG8_LDA
#undef PG8_LDB
#undef PG8_MMA
#undef PG8_WAIT_V
#undef PG8_WAIT_L
#undef PG8_BAR
#undef PG8_SCHED
}
}
#define XB_TMO      128
#define XB_XCNT(j)  (256  + 64 * (j))
#define XB_XSUB(j)  (1280 + 64 * (j))
#define XB_XGEN(j)  (2304 + 64 * (j))
#define XB_TOP      3328
#define XB_TOPGEN   3392
#define XCD_BAR_WORDS 3456
#define XB_SPIN_CAP (1u << 18)

__device__ __forceinline__ unsigned xb_ld(unsigned* p)              { return __hip_atomic_load(p, __ATOMIC_RELAXED, __HIP_MEMORY_SCOPE_AGENT); }
__device__ __forceinline__ unsigned xb_add(unsigned* p, unsigned v) { return __hip_atomic_fetch_add(p, v, __ATOMIC_RELAXED, __HIP_MEMORY_SCOPE_AGENT); }
__device__ __forceinline__ unsigned xb_xcc_id() { return (unsigned)__builtin_amdgcn_s_getreg((3 << 11) | 20) & 0xFu; }
#define XB_SPIN(cond, bar) do { unsigned _sp = 0; while (cond) { __builtin_amdgcn_s_sleep(1); \
    if ((++_sp & 255u) == 0u) { if (xb_ld(&(bar)[XB_TMO])) break; if (_sp > XB_SPIN_CAP) { atomicAdd(&(bar)[XB_TMO], 1u); break; } } } } while (0)

struct XcdBarrier {
    unsigned* bar; unsigned x;
    volatile LAS unsigned* st;
};

__device__ __forceinline__ XcdBarrier xcd_barrier_post(unsigned* bar, volatile LAS unsigned* st) {
    XcdBarrier b; b.bar = bar; b.x = xb_xcc_id(); b.st = st;
    if (threadIdx.x == 0) (void)xb_add(&bar[XB_XCNT(b.x)], 1u);
    return b;
}
__device__ __forceinline__ void xcd_barrier_complete(unsigned* bar, unsigned x, unsigned& nloc, unsigned& nx) {
    const unsigned G = gridDim.x * gridDim.y * gridDim.z;
    unsigned sum, cnt, mine, sp = 0u;
    for (;;) {
        sum = 0u; cnt = 0u; mine = 0u;
#pragma unroll
        for (unsigned j = 0; j < 16; ++j) { const unsigned c = xb_ld(&bar[XB_XCNT(j)]); sum += c; cnt += (c > 0u) ? 1u : 0u; mine = (j == x) ? c : mine; }
        if (sum == G) break;
        __builtin_amdgcn_s_sleep(1);
        if ((++sp & 255u) == 0u) { if (xb_ld(&bar[XB_TMO])) break; if (sp > XB_SPIN_CAP) { atomicAdd(&bar[XB_TMO], 1u); break; } }
    }
    nloc = mine > 0u ? mine : 1u; nx = cnt > 0u ? cnt : 1u;
}

__device__ __forceinline__ void xcd_barrier(const XcdBarrier& b) {
    asm volatile("s_waitcnt vmcnt(0)" ::: "memory");
    __syncthreads();
    if (threadIdx.x == 0) {
        unsigned* bar = b.bar;
        __builtin_amdgcn_s_waitcnt(0);
        unsigned nloc = b.st[0], nx = b.st[1];
        if (nloc == 0u) { xcd_barrier_complete(bar, b.x, nloc, nx); b.st[0] = nloc; b.st[1] = nx; }
        const unsigned old = xb_add(&bar[XB_XSUB(b.x)], 1u);
        const unsigned gen = old / nloc;
        if (old + 1u == (gen + 1u) * nloc) {
            __builtin_amdgcn_fence(__ATOMIC_RELEASE, "agent");
            asm volatile("s_waitcnt vmcnt(0)" ::: "memory");
            const unsigned og = xb_add(&bar[XB_TOP], 1u);
            const unsigned tg = og / nx;
            if (og + 1u == (tg + 1u) * nx) xb_add(&bar[XB_TOPGEN], 1u);
            else XB_SPIN(xb_ld(&bar[XB_TOPGEN]) == tg, bar);
            __builtin_amdgcn_fence(__ATOMIC_ACQUIRE, "agent");
            xb_add(&bar[XB_XGEN(b.x)], 1u);
            asm volatile("s_waitcnt vmcnt(0)" ::: "memory");
        } else {
            XB_SPIN(xb_ld(&bar[XB_XGEN(b.x)]) == gen, bar);
            __builtin_amdgcn_fence(__ATOMIC_ACQUIRE, "agent");
            asm volatile("s_waitcnt vmcnt(0)" ::: "memory");
        }
    }
    __syncthreads();
}
#ifndef N_LAUNCHES
#define N_LAUNCHES 1
#endif
constexpr int MP = 16384, MS = 1024, M = MP + MS, D = 4096, DFF = 11008, NUP = 2 * DFF, NAIN = 8192, NBIN = 16384;
constexpr int NPHASE = 20;
constexpr float ALPHA = 1.41421356237309515f, LN_EPS = 1e-5f, RMS_EPS = 1e-6f;
typedef unsigned short bf16_t;
typedef float f32x4 __attribute__((ext_vector_type(4)));
typedef float f32x2 __attribute__((ext_vector_type(2)));
typedef unsigned u32x4 __attribute__((ext_vector_type(4)));
typedef unsigned u32x2 __attribute__((ext_vector_type(2)));
typedef short bf16x8 __attribute__((ext_vector_type(8)));
typedef short s16x4 __attribute__((ext_vector_type(4)));

constexpr size_t MiB = 1u << 20;
constexpr size_t WS_CTL = 0, CTL_BYTES = 1 * MiB;
constexpr size_t WS_W_AIN = 1 * MiB;
constexpr size_t WS_W_AOUT = WS_W_AIN + 64 * MiB;
constexpr size_t WS_W_UP0 = WS_W_AOUT + 32 * MiB;
constexpr size_t WS_W_DN0 = WS_W_UP0 + 172 * MiB;
constexpr size_t WS_W_BIN = WS_W_DN0 + 86 * MiB;
constexpr size_t WS_W_BOUT = WS_W_BIN + 128 * MiB;
constexpr size_t WS_W_UP1 = WS_W_BOUT + 32 * MiB;
constexpr size_t WS_W_DN1 = WS_W_UP1 + 172 * MiB;
constexpr size_t WS_XB = WS_W_DN1 + 86 * MiB;
constexpr size_t WS_X32 = WS_XB + 136 * MiB;
constexpr size_t WS_H32 = WS_X32 + 272 * MiB;
constexpr size_t WS_STAT = WS_H32 + 272 * MiB;
constexpr size_t WS_ROWSTAT = WS_STAT + 9 * MiB;
constexpr size_t WS_LB = WS_ROWSTAT + 512 * 1024;
constexpr size_t WS_RS2 = WS_ROWSTAT + 768 * 1024;
constexpr size_t WS_BIG = WS_ROWSTAT + 1 * MiB;
constexpr size_t WS_Z = WS_BIG;
constexpr size_t WS_GATED = WS_BIG + 272 * MiB;
constexpr size_t WS_SIDE = WS_BIG;
constexpr size_t WS_HG = WS_BIG + 731 * MiB;
constexpr size_t WS_Q = WS_BIG;
constexpr size_t WS_ZF = WS_BIG + 136 * MiB;
constexpr size_t WS_V = WS_BIG + 272 * MiB;
constexpr size_t WS_G = WS_BIG + 408 * MiB;
constexpr size_t WS_O = WS_BIG + 816 * MiB;
constexpr size_t WS_DCH = WS_BIG + 952 * MiB;
constexpr size_t WS_QS = WS_X32;
constexpr size_t WS_KD = WS_X32 + 136 * MiB;
constexpr size_t WS_SLAB = WS_BIG + 128 * MiB;
constexpr size_t WS_END = WS_BIG + 1097 * MiB;
static_assert(WS_HG + (size_t)M * DFF * 2 <= WS_END && WS_DCH + (size_t)(M / 32) * D * 4 <= WS_END, "ws map");
constexpr size_t OUT_Y = 0, OUT_NV = (size_t)M * D, OUT_SP = OUT_NV + (size_t)MS * D, OUT_SS = OUT_SP + (size_t)4 * 32 * 128 * 128,
                 OUT_CP = OUT_SS + (size_t)32 * 32 * 128 * 128, OUT_CS = OUT_CP + (size_t)2 * 4 * 2 * DFF, OUT_END = OUT_CS + (size_t)2 * 32 * 2 * DFF;
constexpr int LDS_BYTES = 163840, MISC_OFF = LDS_BYTES - 256, PTR_OFF = LDS_BYTES - 512;
constexpr int CW_BAR = 4096;

__device__ __forceinline__ float bf2f(unsigned b16) { return __uint_as_float(b16 << 16); }
typedef __bf16 bf16x2_t __attribute__((ext_vector_type(2)));
__device__ __forceinline__ unsigned pk2(float lo, float hi) { const f32x2 v = {lo, hi}; const bf16x2_t b = __builtin_convertvector(v, bf16x2_t); return __builtin_bit_cast(unsigned, b); }
__device__ __forceinline__ float bflo(unsigned w) { return __uint_as_float(w << 16); }
__device__ __forceinline__ float bfhi(unsigned w) { return __uint_as_float(w & 0xffff0000u); }
__device__ __forceinline__ float wave_sum(float v) {
#pragma unroll
    for (int o = 1; o < 64; o <<= 1) v += __shfl_xor(v, o);
    return v;
}
__device__ __forceinline__ float fexp(float x) { return __builtin_amdgcn_exp2f(x * 1.44269504088896341f); }
__device__ __forceinline__ float frcp(float x) { return __builtin_amdgcn_rcpf(x); }
__device__ __forceinline__ float fsigmoid(float x) { return frcp(1.0f + fexp(-x)); }
__device__ __forceinline__ float fsilu(float x) { return x * fsigmoid(x); }
__device__ __forceinline__ float fgelu_tanh(float x) {
    const float t = x * (1.5957691216057308f + 0.07135481627f * x * x);
    return x * frcp(1.0f + fexp(-t));
}
__device__ __forceinline__ s16x4 lds_tr(LAS unsigned char* p) { return __builtin_amdgcn_ds_read_tr16_b64_v4i16((LAS s16x4*)p); }
__device__ __forceinline__ bf16x8 cat4(s16x4 a, s16x4 b) { return (bf16x8){a[0], a[1], a[2], a[3], b[0], b[1], b[2], b[3]}; }
template <class T> __device__ __forceinline__ T ldo(const void* ubase, unsigned boff) { return *(const T*)((const char*)ubase + boff); }
template <class T> __device__ __forceinline__ void sto(void* ubase, unsigned boff, T v) { *(T*)((char*)ubase + boff) = v; }
#define LDS_WAIT() asm volatile("s_waitcnt lgkmcnt(0)" ::: "memory")
#define VM_WAIT() asm volatile("s_waitcnt vmcnt(0)" ::: "memory")

struct Ctx {
    LAS unsigned char* lds;
    int tid, lane, wave, G, bid;
};
extern __shared__ __attribute__((aligned(16))) unsigned char lds_raw[];
__device__ __forceinline__ Ctx make_ctx() {
    Ctx C; C.lds = (LAS unsigned char*)lds_raw; int t = threadIdx.x; asm volatile("" : "+v"(t));
    C.tid = t; C.lane = t & 63; C.wave = __builtin_amdgcn_readfirstlane(t >> 6); C.G = gridDim.x; C.bid = blockIdx.x; return C;
}
__device__ __forceinline__ unsigned long long ptab(const Ctx& C, int k) {
    const unsigned lo = *(volatile LAS unsigned*)(C.lds + PTR_OFF + 8 * k), hi = *(volatile LAS unsigned*)(C.lds + PTR_OFF + 8 * k + 4);
    return ((unsigned long long)(unsigned)__builtin_amdgcn_readfirstlane((int)hi) << 32) | (unsigned)__builtin_amdgcn_readfirstlane((int)lo);
}
__device__ __forceinline__ const float* inp(const Ctx& C, int k) { return (const float*)(GAS const float*)ptab(C, k); }
__device__ __forceinline__ float* outp(const Ctx& C) { return (float*)(GAS float*)ptab(C, 22); }
__device__ __forceinline__ unsigned char* wsp(const Ctx& C) { return (unsigned char*)(GAS unsigned char*)ptab(C, 23); }
__device__ __forceinline__ const float* xin_row(const float* xp, const float* xs, int row) { return row < MP ? xp + (size_t)row * D : xs + (size_t)(row - MP) * D; }

struct EpiGelu {
    static constexpr bool PERM = true, AFTER_DRAIN = false;
    bf16_t* Z; float* stat;
    __device__ __forceinline__ void operator()(const pg8::f32x4 (&acc)[2][2][4][2], const pg8::Unit& u, int wr, int wc, int fr, int fq) const {
        const int row0 = u.pm * 256 + wr * 64 + fr, col0 = u.pn * 256 + wc * 32 + 8 * fq;
        const bool isv = u.pn >= 16;
#pragma unroll
        for (int ai = 0; ai < 2; ++ai)
#pragma unroll
            for (int m = 0; m < 4; ++m) {
                const int row = row0 + ai * 128 + m * 16; float s1 = 0.f, s2 = 0.f;
#pragma unroll
                for (int bj = 0; bj < 2; ++bj) {
                    float z[8];
#pragma unroll
                    for (int j = 0; j < 4; ++j) { z[j] = fgelu_tanh(acc[ai][bj][m][0][j]); z[4 + j] = fgelu_tanh(acc[ai][bj][m][1][j]); }
#pragma unroll
                    for (int j = 0; j < 8; ++j) { s1 += z[j]; s2 += z[j] * z[j]; }
                    u32x4 w; w.x = pk2(z[0], z[1]); w.y = pk2(z[2], z[3]); w.z = pk2(z[4], z[5]); w.w = pk2(z[6], z[7]);
                    *(u32x4*)(Z + (size_t)row * NAIN + col0 + bj * 128) = w;
                }
                if (isv) {
                    s1 += __shfl_xor(s1, 16); s1 += __shfl_xor(s1, 32); s2 += __shfl_xor(s2, 16); s2 += __shfl_xor(s2, 32);
                    if (fq == 0) *(f32x2*)(stat + ((size_t)row * 64 + (u.pn - 16) * 4 + wc) * 2) = (f32x2){s1, s2};
                }
            }
    }
};
template <int MODE> struct EpiRes {
    static constexpr bool PERM = true, AFTER_DRAIN = false;
    const float* xa; const float* xb; const f32x2* rs; const float* lng; const float* lnb;
    bf16_t* H; float* stat;
    __device__ __forceinline__ void operator()(const pg8::f32x4 (&acc)[2][2][4][2], const pg8::Unit& u, int wr, int wc, int fr, int fq) const { run<0, 2>(acc, u, wr, wc, fr, fq); }
    template <int AI0, int AI1> __device__ __forceinline__ void run(const pg8::f32x4 (&acc)[2][2][4][2], const pg8::Unit& u, int wr, int wc, int fr, int fq) const {
        const int row0 = u.pm * 256 + wr * 64 + fr, col0 = u.pn * 256 + wc * 32 + 8 * fq;
        const float* xbase = nullptr;
        if (MODE == 0) xbase = (u.pm < MP / 256) ? xa + (size_t)row0 * D : xb + (size_t)(row0 - MP) * D;
        float s1[8], s2[8];
#pragma unroll
        for (int i = 0; i < 8; ++i) { s1[i] = 0.f; s2[i] = 0.f; }
#pragma unroll
        for (int bj = 0; bj < 2; ++bj) {
            f32x4 g0, g1, b0, b1;
            if (MODE == 1) { const float* gp = lng + col0 + bj * 128; const float* bp = lnb + col0 + bj * 128; g0 = *(const f32x4*)gp; g1 = *(const f32x4*)(gp + 4); b0 = *(const f32x4*)bp; b1 = *(const f32x4*)(bp + 4); }
#pragma unroll
            for (int ai = AI0; ai < AI1; ++ai)
#pragma unroll
                for (int m = 0; m < 4; ++m) {
                    const int ro = ai * 128 + m * 16;
                    bf16_t* hp = H + (size_t)(row0 + ro) * D + col0 + bj * 128;
                    f32x4 x0, x1;
                    if (MODE == 0) { const float* xp = xbase + (size_t)ro * D + col0 + bj * 128; x0 = *(const f32x4*)xp; x1 = *(const f32x4*)(xp + 4); }
                    else { const f32x2 st = rs[row0 + ro]; const u32x4 hw = *(const u32x4*)hp;
                        x0 = ((f32x4){bflo(hw.x), bfhi(hw.x), bflo(hw.y), bfhi(hw.y)} - st[0]) * st[1] * g0 + b0; x1 = ((f32x4){bflo(hw.z), bfhi(hw.z), bflo(hw.w), bfhi(hw.w)} - st[0]) * st[1] * g1 + b1; }
                    const f32x4 h0 = x0 * ALPHA + acc[ai][bj][m][0], h1 = x1 * ALPHA + acc[ai][bj][m][1];
                    *(u32x4*)hp = (u32x4){pk2(h0[0], h0[1]), pk2(h0[2], h0[3]), pk2(h1[0], h1[1]), pk2(h1[2], h1[3])};
#pragma unroll
                    for (int j = 0; j < 4; ++j) { s1[ai * 4 + m] += h0[j] + h1[j]; s2[ai * 4 + m] += h0[j] * h0[j] + h1[j] * h1[j]; }
                    asm volatile("" ::: "memory");
                }
        }
#pragma unroll
        for (int i = AI0 * 4; i < AI1 * 4; ++i) {
            float a = s1[i], q = s2[i];
            a += __shfl_xor(a, 16); a += __shfl_xor(a, 32); q += __shfl_xor(q, 16); q += __shfl_xor(q, 32);
            if (fq == 0) *(f32x2*)(stat + ((size_t)(row0 + (i >> 2) * 128 + (i & 3) * 16) * 64 + u.pn * 4 + wc) * 2) = (f32x2){a, q};
        }
    }
};
struct EpiNull {
    static constexpr bool PERM = true, AFTER_DRAIN = false;
    float* sink;
    __device__ __forceinline__ void operator()(const pg8::f32x4 (&acc)[2][2][4][2], const pg8::Unit& u, int wr, int wc, int fr, int fq) const {
        float s = 0.f;
#pragma unroll
        for (int ai = 0; ai < 2; ++ai)
#pragma unroll
            for (int bj = 0; bj < 2; ++bj)
#pragma unroll
                for (int m = 0; m < 4; ++m)
#pragma unroll
                    for (int n = 0; n < 2; ++n) s += acc[ai][bj][m][n][0] + acc[ai][bj][m][n][1] + acc[ai][bj][m][n][2] + acc[ai][bj][m][n][3];
        if (s == 12345.678f) sink[u.pm * 64 + fr] = s;
    }
};
constexpr int CW_Q = 8192, CW_CV = 16384;
struct QueueOrder {
    pg8::StaticOrder b; unsigned* q; int x; volatile LAS int* slot;
    __device__ __forceinline__ int issue(int, int wid, int lane) const {
        int L = -1;
        if (wid == 0 && lane == 0) {
            for (int y = 0; y < 8; ++y) {
                const int x2 = (x + y) & 7; const unsigned t = __hip_atomic_fetch_add(q + 64 * x2, 1u, __ATOMIC_RELAXED, __HIP_MEMORY_SCOPE_AGENT);
                const long Lc = (long)t * 8 + x2; if (Lc < b.cap) { L = (int)Lc; break; }
            }
        }
        return L;
    }
    __device__ __forceinline__ bool resolve(int L, int i, pg8::Unit& u, int wid, int lane) const {
        if (wid == 0 && lane == 0) slot[i & 1] = L;
        asm volatile("s_waitcnt lgkmcnt(0)" ::: "memory"); __builtin_amdgcn_s_barrier(); asm volatile("" ::: "memory");
        const int Lr = __builtin_amdgcn_readfirstlane(slot[i & 1]);
        return Lr >= 0 && b.unit_of(Lr, u);
    }
    __device__ __forceinline__ void a_ready(const pg8::Unit&) const {}
    __device__ __forceinline__ void done(const pg8::Unit&) const {}
};
__device__ __forceinline__ QueueOrder make_queue(const Ctx& C, unsigned char* ws_, int pid, int Mr, int Nc) {
    QueueOrder S; S.b.init(Mr, Nc, C.G, 0); S.q = (unsigned*)(ws_ + WS_CTL) + CW_Q + pid * 8 * 64; S.x = C.bid & 7; S.slot = (volatile LAS int*)(C.lds + MISC_OFF) + 16; return S;
}
struct SplitOrder {
    pg8::StaticOrder b; long L;
    __device__ bool next(int i, pg8::Unit& u) const { return i == 0 && b.unit_of(L, u); }
    __device__ __forceinline__ int issue(int, int, int) const { return 0; }
    __device__ __forceinline__ bool resolve(int, int i, pg8::Unit& u, int, int) const { return next(i, u); }
    __device__ __forceinline__ void a_ready(const pg8::Unit&) const {}
    __device__ __forceinline__ void done(const pg8::Unit&) const {}
};
struct EpiPartial {
    static constexpr bool PERM = true, AFTER_DRAIN = false;
    float* slab;
    __device__ __forceinline__ void operator()(const pg8::f32x4 (&acc)[2][2][4][2], const pg8::Unit&, int wr, int wc, int fr, int fq) const {
        const unsigned t = (unsigned)(((wr * 4 + wc) * 4 + fq) * 16 + fr);
#pragma unroll
        for (int ai = 0; ai < 2; ++ai)
#pragma unroll
            for (int bj = 0; bj < 2; ++bj)
#pragma unroll
                for (int m = 0; m < 4; ++m)
#pragma unroll
                    for (int n = 0; n < 2; ++n) sto<pg8::f32x4>(slab, ((unsigned)((((ai * 2 + bj) * 4 + m) * 2 + n) * 512) + t) * 16u, acc[ai][bj][m][n]);
    }
};
struct EpiUpConv {
    static constexpr bool PERM = true, AFTER_DRAIN = false;
    bf16_t* HG; bf16_t* SIDE; float* cp; float* cs; const float* cw; const float* cb;
    __device__ __forceinline__ void operator()(const pg8::f32x4 (&acc)[2][2][4][2], const pg8::Unit& u, int wr, int wc, int fr, int fq) const {
        const int row0 = u.pm * 256 + wr * 64 + fr, ch0 = u.pn * 128 + wc * 32 + 8 * fq;
        const int lane = fq * 16 + fr, L1 = (lane & 48) | ((fr - 1) & 15), L2 = (lane & 48) | ((fr - 2) & 15);
        f32x4 w0[2], w1[2], w2[2], bb[2];
#pragma unroll
        for (int n = 0; n < 2; ++n) { w0[n] = *(const f32x4*)(cw + ch0 + 4 * n); w1[n] = *(const f32x4*)(cw + DFF + ch0 + 4 * n); w2[n] = *(const f32x4*)(cw + 2 * DFF + ch0 + 4 * n); bb[n] = *(const f32x4*)(cb + ch0 + 4 * n); }
#pragma unroll
        for (int ai = 0; ai < 2; ++ai) {
            f32x4 s1p[2], s2p[2];
#pragma unroll
            for (int n = 0; n < 2; ++n) { s1p[n] = (f32x4){0.f, 0.f, 0.f, 0.f}; s2p[n] = s1p[n]; }
#pragma unroll
            for (int m = 0; m < 4; ++m) {
                const int row = row0 + ai * 128 + m * 16, t = row & 31;
                u32x2 ow[2];
#pragma unroll
                for (int n = 0; n < 2; ++n) {
                    const pg8::f32x4 a = acc[ai][0][m][n], uu = acc[ai][1][m][n];
                    f32x4 s1, s2, o;
#pragma unroll
                    for (int j = 0; j < 4; ++j) { s1[j] = __shfl(a[j], L1); s2[j] = __shfl(a[j], L2); }
#pragma unroll
                    for (int j = 0; j < 4; ++j) {
                        const float p1 = fr >= 1 ? s1[j] : s1p[n][j], p2 = fr >= 2 ? s2[j] : s2p[n][j];
                        const float c = bb[n][j] + p2 * w0[n][j] + p1 * w1[n][j] + a[j] * w2[n][j];
                        o[j] = fsilu(c) * uu[j];
                    }
                    s1p[n] = s1; s2p[n] = s2;
                    ow[n].x = pk2(o[0], o[1]); ow[n].y = pk2(o[2], o[3]);
                }
                const bool inwave = (m == 2) && (u.pm < MP / 256);
                if (t >= 2 || inwave) *(u32x4*)(HG + (size_t)row * DFF + ch0) = (u32x4){ow[0].x, ow[0].y, ow[1].x, ow[1].y};
                if ((t < 2 && !inwave) || t >= 30) {
                    const pg8::f32x4 a0 = acc[ai][0][m][0], a1 = acc[ai][0][m][1];
                    bf16_t* sd = SIDE + ((size_t)(row >> 5) * 6 + (t >= 30 ? t - 30 : t + 2)) * DFF + ch0;
                    *(u32x4*)sd = (u32x4){pk2(a0[0], a0[1]), pk2(a0[2], a0[3]), pk2(a1[0], a1[1]), pk2(a1[2], a1[3])};
                    if (t < 2) { const pg8::f32x4 u0 = acc[ai][1][m][0], u1 = acc[ai][1][m][1];
                        *(u32x4*)(sd + 2 * DFF) = (u32x4){pk2(u0[0], u0[1]), pk2(u0[2], u0[3]), pk2(u1[0], u1[1]), pk2(u1[2], u1[3])}; }
                    float* dst = nullptr;
                    if (row < MP) { const int tq = row & 4095; if (tq >= 4094) dst = cp + ((size_t)(row >> 12) * 2 + (tq - 4094)) * DFF + ch0; }
                    else if (t >= 30) dst = cs + ((size_t)((row - MP) >> 5) * 2 + (t - 30)) * DFF + ch0;
                    if (dst) { *(f32x4*)dst = a0; *(f32x4*)(dst + 4) = a1; }
                }
            }
        }
    }
};
struct EpiBin {
    static constexpr bool PERM = true, AFTER_DRAIN = false;
    unsigned char* ws;
    __device__ __forceinline__ void operator()(const pg8::f32x4 (&acc)[2][2][4][2], const pg8::Unit& u, int wr, int wc, int fr, int fq) const {
        const int row0 = u.pm * 256 + wr * 64 + fr;
        if (u.pn >= 32) {
            const int col0 = (u.pn & 15) * 256 + wc * 32 + 8 * fq, sel = u.pn >> 4;
            bf16_t* dst = (bf16_t*)(ws + WS_Q + (size_t)sel * (136 * MiB));
#pragma unroll
            for (int ai = 0; ai < 2; ++ai)
#pragma unroll
                for (int m = 0; m < 4; ++m)
#pragma unroll
                    for (int bj = 0; bj < 2; ++bj) {
                        const pg8::f32x4 v0 = acc[ai][bj][m][0], v1 = acc[ai][bj][m][1];
                        u32x4 w; w.x = pk2(v0[0], v0[1]); w.y = pk2(v0[2], v0[3]); w.z = pk2(v1[0], v1[1]); w.w = pk2(v1[2], v1[3]);
                        *(u32x4*)(dst + (size_t)(row0 + ai * 128 + m * 16) * D + col0 + bj * 128) = w;
                    }
            return;
        }
        const int ch0 = u.pn * 128 + wc * 32 + 8 * fq;
        bf16_t* QS = (bf16_t*)(ws + WS_QS); bf16_t* KD = (bf16_t*)(ws + WS_KD); float* DCH = (float*)(ws + WS_DCH); const float* LB = (const float*)(ws + WS_LB);
        const f32x4 lb0 = *(const f32x4*)(LB + ch0), lb1 = *(const f32x4*)(LB + ch0 + 4);
        const int l15 = (fq * 16 + 15) * 4;
#pragma unroll
        for (int ai = 0; ai < 2; ++ai)
#pragma unroll
            for (int mp = 0; mp < 2; ++mp) {
                unsigned wq0[4], wq1[4], wk0[4], wk1[4];
#pragma unroll
                for (int n = 0; n < 2; ++n) {
                    const f32x4 lb = n ? lb1 : lb0;
                    float k0[4], k1[4], b0[4], b1[4];
#pragma unroll
                    for (int j = 0; j < 4; ++j) {
                        const float om = 1.0f - lb[j];
                        const float e0 = fexp(-acc[ai][1][2 * mp][n][j]), e1 = fexp(-acc[ai][1][2 * mp + 1][n][j]);
                        const float r0 = frcp(1.0f + e0), r1 = frcp(1.0f + e1);
                        k0[j] = om * e0 * r0; k1[j] = om * e1 * r1;
                        b0[j] = __builtin_amdgcn_logf(lb[j] + om * r0); b1[j] = __builtin_amdgcn_logf(lb[j] + om * r1);
                    }
#pragma unroll
                    for (int j = 0; j < 4; ++j) {
                        b0[j] += __int_as_float(__builtin_amdgcn_update_dpp(0, __float_as_int(b0[j]), 0x111, 0xf, 0xf, true));
                        b1[j] += __int_as_float(__builtin_amdgcn_update_dpp(0, __float_as_int(b1[j]), 0x111, 0xf, 0xf, true));
                    }
#pragma unroll
                    for (int j = 0; j < 4; ++j) {
                        b0[j] += __int_as_float(__builtin_amdgcn_update_dpp(0, __float_as_int(b0[j]), 0x112, 0xf, 0xf, true));
                        b1[j] += __int_as_float(__builtin_amdgcn_update_dpp(0, __float_as_int(b1[j]), 0x112, 0xf, 0xf, true));
                    }
#pragma unroll
                    for (int j = 0; j < 4; ++j) {
                        b0[j] += __int_as_float(__builtin_amdgcn_update_dpp(0, __float_as_int(b0[j]), 0x114, 0xf, 0xf, true));
                        b1[j] += __int_as_float(__builtin_amdgcn_update_dpp(0, __float_as_int(b1[j]), 0x114, 0xf, 0xf, true));
                    }
#pragma unroll
                    for (int j = 0; j < 4; ++j) {
                        b0[j] += __int_as_float(__builtin_amdgcn_update_dpp(0, __float_as_int(b0[j]), 0x118, 0xf, 0xf, true));
                        b1[j] += __int_as_float(__builtin_amdgcn_update_dpp(0, __float_as_int(b1[j]), 0x118, 0xf, 0xf, true));
                    }
                    float qs0[4], qs1[4], kd0[4], kd1[4]; f32x4 et;
#pragma unroll
                    for (int j = 0; j < 4; ++j) {
                        b1[j] += __int_as_float(__builtin_amdgcn_ds_bpermute(l15, __float_as_int(b0[j])));
                        const float eb0 = __builtin_amdgcn_exp2f(b0[j]), eb1 = __builtin_amdgcn_exp2f(b1[j]);
                        qs0[j] = acc[ai][0][2 * mp][n][j] * eb0; qs1[j] = acc[ai][0][2 * mp + 1][n][j] * eb1;
                        kd0[j] = k0[j] * frcp(eb0); kd1[j] = k1[j] * frcp(eb1);
                        et[j] = eb1;
                    }
                    wq0[2 * n] = pk2(qs0[0], qs0[1]); wq0[2 * n + 1] = pk2(qs0[2], qs0[3]); wq1[2 * n] = pk2(qs1[0], qs1[1]); wq1[2 * n + 1] = pk2(qs1[2], qs1[3]);
                    wk0[2 * n] = pk2(kd0[0], kd0[1]); wk0[2 * n + 1] = pk2(kd0[2], kd0[3]); wk1[2 * n] = pk2(kd1[0], kd1[1]); wk1[2 * n + 1] = pk2(kd1[2], kd1[3]);
                    if (fr == 15) *(f32x4*)(DCH + (size_t)(u.pm * 8 + ai * 4 + wr * 2 + mp) * D + ch0 + 4 * n) = et;
                }
                const size_t o0 = (size_t)(row0 + ai * 128 + mp * 32) * D + ch0, o1 = o0 + (size_t)16 * D;
                u32x4 w;
                w.x = wq0[0]; w.y = wq0[1]; w.z = wq0[2]; w.w = wq0[3]; *(u32x4*)(QS + o0) = w;
                w.x = wq1[0]; w.y = wq1[1]; w.z = wq1[2]; w.w = wq1[3]; *(u32x4*)(QS + o1) = w;
                w.x = wk0[0]; w.y = wk0[1]; w.z = wk0[2]; w.w = wk0[3]; *(u32x4*)(KD + o0) = w;
                w.x = wk1[0]; w.y = wk1[1]; w.z = wk1[2]; w.w = wk1[3]; *(u32x4*)(KD + o1) = w;
            }
    }
};

struct CvItem { const float* src; bf16_t* dst; int K, N; };
__device__ __forceinline__ void cv_load(const CvItem& d, int lane, f32x4 (&x)[16]) {
    const unsigned lo = (unsigned)((lane >> 4) * d.N + 4 * (lane & 15)) * 4u, step = (unsigned)d.N * 16u;
#pragma unroll
    for (int i = 0; i < 16; ++i) x[i] = __builtin_nontemporal_load((const f32x4*)((const char*)d.src + lo + (unsigned)i * step));
}
__device__ __forceinline__ void cv_store(const CvItem& d, int lane, const f32x4 (&x)[16], LAS float* scr) {
#pragma unroll
    for (int i = 0; i < 16; ++i) {
        LAS float* p = scr + (4 * i + (lane >> 4)) * 65 + 4 * (lane & 15);
        p[0] = x[i][0]; p[1] = x[i][1]; p[2] = x[i][2]; p[3] = x[i][3];
    }
    LDS_WAIT();
    const int c = lane & 7;
#pragma unroll
    for (int j = 0; j < 8; ++j) {
        const int n = (lane >> 3) + 8 * j; const LAS float* s = scr + (8 * c) * 65 + n;
        u32x4 o; o.x = pk2(s[0], s[65]); o.y = pk2(s[2 * 65], s[3 * 65]); o.z = pk2(s[4 * 65], s[5 * 65]); o.w = pk2(s[6 * 65], s[7 * 65]);
        __builtin_nontemporal_store(o, (u32x4*)((char*)d.dst + (unsigned)(n * d.K + 8 * c) * 2u));
    }
    LDS_WAIT();
}
constexpr int I_AIN = 64 * 128, I_AOUT = 64 * 64, I_BIN = 64 * 256, I_BOUT = 64 * 64, I_UP = 64 * 344, I_DN = 172 * 64;
constexpr int CV_DN0A = 7400, CV_UP0A = 6000;
constexpr int CV_S0 = 0;
constexpr int CV_S1 = CV_S0 + I_AIN + CV_DN0A;
constexpr int CV_S2 = CV_S1 + I_AOUT + CV_UP0A;
constexpr int CV_S3 = CV_S2 + (I_UP - CV_UP0A);
constexpr int CV_S4 = CV_S3 + (I_DN - CV_DN0A);
constexpr int CV_S4B = CV_S4 + I_BIN + I_BOUT + I_UP / 2;
constexpr int CV_S5 = CV_S4B + I_UP - I_UP / 2 - 4000;
constexpr int CV_END = CV_S4B + (I_UP - I_UP / 2) + I_DN;
__device__ __forceinline__ CvItem cv_decode(const Ctx& C, unsigned char* ws_, int it) {
    int r = it; const float* W; bf16_t* WT; int K, N, kind = 0;
    if (r < I_AIN) { W = inp(C, 4); WT = (bf16_t*)(ws_ + WS_W_AIN); K = D; N = NAIN; }
    else if ((r -= I_AIN) < CV_DN0A) { W = inp(C, 17); WT = (bf16_t*)(ws_ + WS_W_DN0); K = DFF; N = D; }
    else if ((r -= CV_DN0A) < I_AOUT) { W = inp(C, 9); WT = (bf16_t*)(ws_ + WS_W_AOUT); K = D; N = D; }
    else if ((r -= I_AOUT) < I_UP) { W = inp(C, 14); WT = (bf16_t*)(ws_ + WS_W_UP0); K = D; N = NUP; kind = 1; }
    else if ((r -= I_UP) < I_DN - CV_DN0A) { r += CV_DN0A; W = inp(C, 17); WT = (bf16_t*)(ws_ + WS_W_DN0); K = DFF; N = D; }
    else if ((r -= I_DN - CV_DN0A) < I_BIN) { W = inp(C, 10); WT = (bf16_t*)(ws_ + WS_W_BIN); K = D; N = NBIN; kind = 2; }
    else if ((r -= I_BIN) < I_BOUT) { W = inp(C, 13); WT = (bf16_t*)(ws_ + WS_W_BOUT); K = D; N = D; }
    else if ((r -= I_BOUT) < I_UP) { W = inp(C, 14) + (size_t)D * NUP; WT = (bf16_t*)(ws_ + WS_W_UP1); K = D; N = NUP; kind = 1; }
    else { r -= I_UP; W = inp(C, 17) + (size_t)DFF * D; WT = (bf16_t*)(ws_ + WS_W_DN1); K = DFF; N = D; }
    const int nblk = N / 64, kb = r / nblk, nb = r % nblk, n0 = nb * 64;
    int drow0 = n0;
    if (kind == 1) { const int h = n0 >= DFF ? 1 : 0, c = n0 - h * DFF; drow0 = 256 * (c >> 7) + 128 * h + (c & 127); }
    if (kind == 2 && n0 < 2 * D) { const int h = n0 >= D ? 1 : 0, c = n0 - h * D; drow0 = 256 * (c >> 7) + 128 * h + (c & 127); }
    CvItem d; d.src = W + (size_t)(kb * 64) * N + n0; d.dst = WT + (size_t)drow0 * K + kb * 64; d.K = K; d.N = N; return d;
}
__device__ __forceinline__ void conv_range(const Ctx& C, int lo, int hi, int rank, int nranks) {
    unsigned char* const ws_ = wsp(C);
    LAS float* scr = (LAS float*)(C.lds + C.wave * 16640);
    int it = lo + rank;
    if (it >= hi) return;
    CvItem d = cv_decode(C, ws_, it); f32x4 cur[16], nxt[16];
    cv_load(d, C.lane, cur);
    for (;;) {
        const int itn = it + nranks; const bool more = itn < hi;
        CvItem dn = d;
        if (more) { dn = cv_decode(C, ws_, itn); cv_load(dn, C.lane, nxt); }
        cv_store(d, C.lane, cur, scr);
        if (!more) break;
#pragma unroll
        for (int i = 0; i < 16; ++i) cur[i] = nxt[i];
        d = dn; it = itn;
    }
}
__device__ __forceinline__ void conv_queue(const Ctx& C, int seg, int lo, int hi) {
    unsigned char* const ws_ = wsp(C);
    unsigned* ctr = (unsigned*)(ws_ + WS_CTL) + CW_CV + seg * 64;
    LAS float* scr = (LAS float*)(C.lds + C.wave * 16640);
    for (;;) {
        unsigned t = 0; if (C.lane == 0) t = __hip_atomic_fetch_add(ctr, 1u, __ATOMIC_RELAXED, __HIP_MEMORY_SCOPE_AGENT);
        t = (unsigned)__builtin_amdgcn_readfirstlane((int)t);
        const int it0 = lo + (int)t * 4; if (it0 >= hi) break;
        for (int it = it0; it < it0 + 4 && it < hi; ++it) { const CvItem d = cv_decode(C, ws_, it); f32x4 x[16]; cv_load(d, C.lane, x); cv_store(d, C.lane, x, scr); }
    }
    __syncthreads();
}
__device__ __forceinline__ void conv_tail(const Ctx& C, int nwg, int lo, int hi) {
    const int R = (nwg + C.G - 1) / C.G - 1, nbusy = nwg - R * C.G;
    if (nbusy >= C.G) conv_range(C, lo, hi, C.bid * 8 + C.wave, C.G * 8);
    else if (C.bid >= nbusy) conv_range(C, lo, hi, (C.bid - nbusy) * 8 + C.wave, (C.G - nbusy) * 8);
    __syncthreads();
}
__device__ __forceinline__ void p0_prologue(const Ctx& C0) {
    const Ctx C = C0;
    unsigned char* const ws_ = wsp(C);
    conv_range(C, CV_S0, CV_S1, C.bid * 8 + C.wave, C.G * 8);
    bf16_t* XB = (bf16_t*)(ws_ + WS_XB); const float* const xp_ = inp(C, 0); const float* const xs_ = inp(C, 1);
    for (size_t i = (size_t)C.bid * 512 + C.tid; i < (size_t)M * D / 8; i += (size_t)C.G * 512) {
        const int row = (int)(i >> 9), c8 = (int)(i & 511);
        const float* xr = xin_row(xp_, xs_, row) + c8 * 8;
        const f32x4 a = *(const f32x4*)xr, b = *(const f32x4*)(xr + 4);
        u32x4 w; w.x = pk2(a[0], a[1]); w.y = pk2(a[2], a[3]); w.z = pk2(b[0], b[1]); w.w = pk2(b[2], b[3]);
        *(u32x4*)(XB + (size_t)row * D + c8 * 8) = w;
    }
    float* LB = (float*)(ws_ + WS_LB);
    const float* const blb_ = inp(C, 11);
    for (int i = C.bid * 512 + C.tid; i < D; i += C.G * 512) { const float b0 = blb_[i], b1 = blb_[D + i]; LB[i] = 1.0f / (1.0f + expf(b0 - b1)); }
}

__device__ __forceinline__ void p_rowstat(const Ctx& C0) {
    const Ctx C = C0;
    unsigned char* const ws_ = wsp(C);
    const f32x2* stat = (const f32x2*)(ws_ + WS_STAT); f32x2* rs = (f32x2*)(ws_ + WS_ROWSTAT);
    for (int row = C.bid * 8 + C.wave; row < M; row += C.G * 8) {
        const f32x2 sl = stat[(size_t)row * 64 + C.lane];
        const float s1 = wave_sum(sl[0]), s2 = wave_sum(sl[1]);
        const float mean = s1 * (1.0f / D), var = s2 * (1.0f / D) - mean * mean;
        if (C.lane == 0) rs[row] = (f32x2){mean, 1.0f / sqrtf(var + LN_EPS)};
    }
}
__device__ __forceinline__ void p_ln_apply(const Ctx& C0, const float* g, const float* b, bf16_t* XBo, float* Yo) {
    const Ctx C = C0;
    unsigned char* const ws_ = wsp(C);
    const bf16_t* H = (const bf16_t*)(ws_ + WS_H32); const f32x2* stat = (const f32x2*)(ws_ + WS_STAT); f32x2* rs2 = (f32x2*)(ws_ + WS_RS2);
    const unsigned loff = (unsigned)C.lane * 16u;
    for (int row = C.bid * 8 + C.wave; row < M; row += C.G * 8) {
        const f32x2 sl = stat[(size_t)row * 64 + C.lane];
        const bf16_t* hr = H + (size_t)row * D;
        u32x4 hw[8];
#pragma unroll
        for (int j = 0; j < 8; ++j) hw[j] = ldo<u32x4>(hr, loff + (unsigned)j * 1024u);
        const float s1 = wave_sum(sl[0]), s2 = wave_sum(sl[1]);
        const float mean = s1 * (1.0f / D), var = s2 * (1.0f / D) - mean * mean, rstd = 1.0f / sqrtf(var + LN_EPS);
        if (C.lane == 0) rs2[row] = (f32x2){mean, rstd};
#pragma unroll
        for (int j = 0; j < 8; ++j) {
            const int c = 512 * j + 8 * C.lane;
            const f32x4 v0 = {bflo(hw[j].x), bfhi(hw[j].x), bflo(hw[j].y), bfhi(hw[j].y)}, v1 = {bflo(hw[j].z), bfhi(hw[j].z), bflo(hw[j].w), bfhi(hw[j].w)};
            const f32x4 g0 = *(const f32x4*)(g + c), g1 = *(const f32x4*)(g + c + 4), b0 = *(const f32x4*)(b + c), b1 = *(const f32x4*)(b + c + 4);
            const f32x4 y0 = (v0 - mean) * rstd * g0 + b0, y1 = (v1 - mean) * rstd * g1 + b1;
            if (Yo) { __builtin_nontemporal_store(y0, (f32x4*)(Yo + (size_t)row * D + c)); __builtin_nontemporal_store(y1, (f32x4*)(Yo + (size_t)row * D + c + 4)); }
            if (XBo) { u32x4 w; w.x = pk2(y0[0], y0[1]); w.y = pk2(y0[2], y0[3]); w.z = pk2(y1[0], y1[1]); w.w = pk2(y1[2], y1[3]); *(u32x4*)(XBo + (size_t)row * D + c) = w; }
        }
    }
}
__device__ __forceinline__ void p_convfix(const Ctx& C0, int layer) {
    const Ctx C = C0;
    unsigned char* const ws_ = wsp(C);
    const bf16_t* SIDE = (const bf16_t*)(ws_ + WS_SIDE); bf16_t* HG = (bf16_t*)(ws_ + WS_HG);
    const float* cw = inp(C, 15) + (size_t)layer * 3 * DFF; const float* cb = inp(C, 16) + (size_t)layer * DFF;
    const float* cache = inp(C, 3) + (size_t)layer * 32 * 2 * DFF;
    constexpr int NCH = DFF / 8, NCK = MP / 64 + (M - MP) / 32;
    for (int task = C.bid * 512 + C.tid; task < NCK * NCH; task += C.G * 512) {
        const int ki = task / NCH, q = task - ki * NCH, c = 8 * q, k = ki < MP / 64 ? 2 * ki : MP / 32 + (ki - MP / 64);
        float w0[8], w1[8], w2[8], bb[8], p1[8], p2[8], a0[8], a1[8], u0[8], u1[8];
#pragma unroll
        for (int j = 0; j < 8; ++j) { w0[j] = cw[c + j]; w1[j] = cw[DFF + c + j]; w2[j] = cw[2 * DFF + c + j]; bb[j] = cb[c + j]; p1[j] = 0.f; p2[j] = 0.f; }
        if (k >= MP / 32) {
            const float* cs = cache + (size_t)(k - MP / 32) * 2 * DFF + c;
#pragma unroll
            for (int j = 0; j < 8; ++j) { p2[j] = cs[j]; p1[j] = cs[DFF + j]; }
        } else if ((k & 127) != 0) {
            const u32x4 x2 = *(const u32x4*)(SIDE + ((size_t)(k - 1) * 6 + 0) * DFF + c), x1 = *(const u32x4*)(SIDE + ((size_t)(k - 1) * 6 + 1) * DFF + c);
#pragma unroll
            for (int j = 0; j < 4; ++j) { p2[2 * j] = bflo(x2[j]); p2[2 * j + 1] = bfhi(x2[j]); p1[2 * j] = bflo(x1[j]); p1[2 * j + 1] = bfhi(x1[j]); }
        }
        const bf16_t* sd = SIDE + (size_t)k * 6 * DFF + c;
        const u32x4 xa0 = *(const u32x4*)(sd + 2 * DFF), xa1 = *(const u32x4*)(sd + 3 * DFF), xu0 = *(const u32x4*)(sd + 4 * DFF), xu1 = *(const u32x4*)(sd + 5 * DFF);
#pragma unroll
        for (int j = 0; j < 4; ++j) { a0[2 * j] = bflo(xa0[j]); a0[2 * j + 1] = bfhi(xa0[j]); a1[2 * j] = bflo(xa1[j]); a1[2 * j + 1] = bfhi(xa1[j]);
                                       u0[2 * j] = bflo(xu0[j]); u0[2 * j + 1] = bfhi(xu0[j]); u1[2 * j] = bflo(xu1[j]); u1[2 * j + 1] = bfhi(xu1[j]); }
        float o0[8], o1[8];
#pragma unroll
        for (int j = 0; j < 8; ++j) {
            const float c0 = bb[j] + p2[j] * w0[j] + p1[j] * w1[j] + a0[j] * w2[j];
            const float c1 = bb[j] + p1[j] * w0[j] + a0[j] * w1[j] + a1[j] * w2[j];
            o0[j] = fsilu(c0) * u0[j]; o1[j] = fsilu(c1) * u1[j];
        }
        *(u32x4*)(HG + (size_t)(32 * k) * DFF + c) = (u32x4){pk2(o0[0], o0[1]), pk2(o0[2], o0[3]), pk2(o0[4], o0[5]), pk2(o0[6], o0[7])};
        *(u32x4*)(HG + (size_t)(32 * k + 1) * DFF + c) = (u32x4){pk2(o1[0], o1[1]), pk2(o1[2], o1[3]), pk2(o1[4], o1[5]), pk2(o1[6], o1[7])};
    }
}

constexpr int SG_WS = 0, SG_VN = 34816, SG_MX = 69632, SG_ROW = 272, SG_MXROW = 528;
__device__ __forceinline__ void p_spatial(const Ctx& C0) {
    const Ctx C = C0;
    unsigned char* const ws_ = wsp(C); float* const out_ = outp(C);
    const bf16_t* Z = (const bf16_t*)(ws_ + WS_Z); bf16_t* GATED = (bf16_t*)(ws_ + WS_GATED);
    const f32x2* rs = (const f32x2*)(ws_ + WS_ROWSTAT);
    const float* w_s = inp(C, 7); const float* b_s = inp(C, 8); const float* ln_g = inp(C, 5); const float* ln_b = inp(C, 6);
    LAS unsigned char* lds = C.lds;
    const int tid = C.tid, lane = C.lane, wave = C.wave, wr = wave >> 2, wc = wave & 3, c16 = lane & 15, hh = lane >> 4, q4 = (lane & 15) >> 2, p4 = lane & 3;
    int cur_g = -1, cur_type = -1;
    float lg[8], lbv[8], bsv[4];
    for (int u = C.bid; u < (M / 128) * 32; u += C.G) {
        const int rb = u >> 5, g = u & 31, r0 = rb * 128, type = (r0 >= MP) ? 1 : 0;
        u32x4 U16[4], V16[4]; f32x2 st[4];
        const int c8 = tid & 15;
#pragma unroll
        for (int k = 0; k < 4; ++k) {
            const int t = (tid >> 4) + 32 * k;
            const bf16_t* zr = Z + (size_t)(r0 + t) * NAIN + g * 128 + c8 * 8;
            U16[k] = *(const u32x4*)zr; V16[k] = *(const u32x4*)(zr + D); st[k] = rs[r0 + t];
        }
        if (g != cur_g || type != cur_type) {
            __syncthreads();
            const int t = tid >> 2, sq = tid & 3;
#pragma unroll
            for (int s8 = 0; s8 < 4; ++s8) {
                const int s0 = 32 * sq + 8 * s8; float wv[8];
                if (type == 0) {
                    const float* src = w_s + ((size_t)g * 128 + t) * 128 + s0;
                    const f32x4 a = *(const f32x4*)src, b = *(const f32x4*)(src + 4);
#pragma unroll
                    for (int j = 0; j < 4; ++j) { wv[j] = (s0 + j <= t) ? a[j] : 0.f; wv[4 + j] = (s0 + 4 + j <= t) ? b[j] : 0.f; }
                } else {
                    const int tl = t & 31, sl = s0 & 31; const bool same = (t >> 5) == (s0 >> 5);
                    const float* src = w_s + ((size_t)g * 128 + tl) * 128 + sl;
                    const f32x4 a = *(const f32x4*)src, b = *(const f32x4*)(src + 4);
#pragma unroll
                    for (int j = 0; j < 4; ++j) { wv[j] = (same && sl + j <= tl) ? a[j] : 0.f; wv[4 + j] = (same && sl + 4 + j <= tl) ? b[j] : 0.f; }
                }
                u32x4 w; w.x = pk2(wv[0], wv[1]); w.y = pk2(wv[2], wv[3]); w.z = pk2(wv[4], wv[5]); w.w = pk2(wv[6], wv[7]);
                *(LAS u32x4*)(lds + SG_WS + t * SG_ROW + s0 * 2) = w;
            }
#pragma unroll
            for (int j = 0; j < 8; ++j) { lg[j] = ln_g[g * 128 + c8 * 8 + j]; lbv[j] = ln_b[g * 128 + c8 * 8 + j]; }
#pragma unroll
            for (int tt = 0; tt < 4; ++tt) { const int t2 = 64 * wr + 16 * tt + c16; bsv[tt] = b_s[g * 128 + (type ? (t2 & 31) : t2)]; }
            cur_g = g; cur_type = type;
        }
#pragma unroll
        for (int k = 0; k < 4; ++k) {
            const int t = (tid >> 4) + 32 * k; float vn[8];
#pragma unroll
            for (int j = 0; j < 4; ++j) {
                vn[2 * j] = (bflo(V16[k][j]) - st[k][0]) * st[k][1] * lg[2 * j] + lbv[2 * j];
                vn[2 * j + 1] = (bfhi(V16[k][j]) - st[k][0]) * st[k][1] * lg[2 * j + 1] + lbv[2 * j + 1];
            }
            if (type) { float* nv = out_ + OUT_NV + (size_t)(r0 + t - MP) * D + g * 128 + c8 * 8;
                *(f32x4*)nv = (f32x4){vn[0], vn[1], vn[2], vn[3]}; *(f32x4*)(nv + 4) = (f32x4){vn[4], vn[5], vn[6], vn[7]}; }
            u32x4 w; w.x = pk2(vn[0], vn[1]); w.y = pk2(vn[2], vn[3]); w.z = pk2(vn[4], vn[5]); w.w = pk2(vn[6], vn[7]);
            *(LAS u32x4*)(lds + SG_VN + t * SG_ROW + c8 * 16) = w;
        }
        __syncthreads();
        f32x4 acc[2][4];
#pragma unroll
        for (int ct = 0; ct < 2; ++ct)
#pragma unroll
            for (int tt = 0; tt < 4; ++tt) acc[ct][tt] = (f32x4){0.f, 0.f, 0.f, 0.f};
#pragma unroll
        for (int kk = 0; kk < 4; ++kk) {
            bf16x8 a[2], b[4];
#pragma unroll
            for (int ct = 0; ct < 2; ++ct) {
                LAS unsigned char* p = lds + SG_VN + (32 * kk + 8 * hh + q4) * SG_ROW + (32 * wc + 16 * ct + 4 * p4) * 2;
                a[ct] = cat4(lds_tr(p), lds_tr(p + 4 * SG_ROW));
            }
#pragma unroll
            for (int tt = 0; tt < 4; ++tt) b[tt] = *(const LAS bf16x8*)(lds + SG_WS + (64 * wr + 16 * tt + c16) * SG_ROW + (32 * kk + 8 * hh) * 2);
#pragma unroll
            for (int ct = 0; ct < 2; ++ct)
#pragma unroll
                for (int tt = 0; tt < 4; ++tt) acc[ct][tt] = __builtin_amdgcn_mfma_f32_16x16x32_bf16(a[ct], b[tt], acc[ct][tt], 0, 0, 0);
        }
#pragma unroll
        for (int ct = 0; ct < 2; ++ct)
#pragma unroll
            for (int tt = 0; tt < 4; ++tt)
                *(LAS f32x4*)(lds + SG_MX + (64 * wr + 16 * tt + c16) * SG_MXROW + (32 * wc + 16 * ct + 4 * hh) * 4) = acc[ct][tt] + bsv[tt];
        __syncthreads();
#pragma unroll
        for (int k = 0; k < 4; ++k) {
            const int t = (tid >> 4) + 32 * k;
            const f32x4 m0 = *(const LAS f32x4*)(lds + SG_MX + t * SG_MXROW + c8 * 32), m1 = *(const LAS f32x4*)(lds + SG_MX + t * SG_MXROW + c8 * 32 + 16);
            u32x4 w;
            w.x = pk2(bflo(U16[k][0]) * m0[0], bfhi(U16[k][0]) * m0[1]); w.y = pk2(bflo(U16[k][1]) * m0[2], bfhi(U16[k][1]) * m0[3]);
            w.z = pk2(bflo(U16[k][2]) * m1[0], bfhi(U16[k][2]) * m1[1]); w.w = pk2(bflo(U16[k][3]) * m1[2], bfhi(U16[k][3]) * m1[3]);
            *(u32x4*)(GATED + (size_t)(r0 + t) * D + g * 128 + c8 * 8) = w;
        }
    }
    __syncthreads();
}


#ifndef GLA_PROMPT_REPS
#define GLA_PROMPT_REPS 1
#endif
constexpr int GL_QS = 0, GL_KD = 8704, GL_V = 17408, GL_G = 26112, GL_DCH = 34816, GL_BUF = 35328, GL_OT = 2 * GL_BUF, GL_OTSZ = 32 * 528, GL_ROW = 272, GL_OTROW = 528;
#define GLA_NORM(PK, GATE) do { const int pk_ = (PK); \
            LAS unsigned char* OTp = lds + GL_OT + (pk_ & 1) * GL_OTSZ; const int orow = 4 * w + hh; \
            const f32x4 x0 = *(const LAS f32x4*)(OTp + orow * GL_OTROW + c16 * 32), x1 = *(const LAS f32x4*)(OTp + orow * GL_OTROW + c16 * 32 + 16); \
            float ss = x0[0] * x0[0] + x0[1] * x0[1] + x0[2] * x0[2] + x0[3] * x0[3] + x1[0] * x1[0] + x1[1] * x1[1] + x1[2] * x1[2] + x1[3] * x1[3]; \
            ss += __shfl_xor(ss, 1); ss += __shfl_xor(ss, 2); ss += __shfl_xor(ss, 4); ss += __shfl_xor(ss, 8); \
            const float rn = 1.0f / sqrtf(ss * (1.0f / 128.0f) + RMS_EPS); \
            u32x4 wv; \
            wv.x = pk2(x0[0] * rn * g0[0] * fsilu(bflo(GATE[0])), x0[1] * rn * g0[1] * fsilu(bfhi(GATE[0]))); \
            wv.y = pk2(x0[2] * rn * g0[2] * fsilu(bflo(GATE[1])), x0[3] * rn * g0[3] * fsilu(bfhi(GATE[1]))); \
            wv.z = pk2(x1[0] * rn * g1[0] * fsilu(bflo(GATE[2])), x1[1] * rn * g1[1] * fsilu(bfhi(GATE[2]))); \
            wv.w = pk2(x1[2] * rn * g1[2] * fsilu(bflo(GATE[3])), x1[3] * rn * g1[3] * fsilu(bfhi(GATE[3]))); \
            sto<u32x4>(O + (size_t)(rbase + 32 * pk_) * D + cb, ooff, wv); } while (0)
#define GLA_STEP(CKV, WRSET, LDSET) do { const int ck = (CKV); \
            LAS unsigned char* B = lds + (ck & 1) * GL_BUF; \
            LAS unsigned char* OT = lds + GL_OT + (ck & 1) * GL_OTSZ; \
            const int r0 = rbase + 32 * ck; \
            const bool more = ck + 1 < nck; \
            const size_t uo = (size_t)r0 * D + cb; \
            { const int c2 = ck + 2 < nck ? ck + 2 : nck - 1;     \
              const size_t u2 = (size_t)(rbase + 32 * c2) * D + cb; LDSET##a = ldo<u32x4>(QS + u2, soff); LDSET##b = ldo<u32x4>(KD + u2, soff); LDSET##d = ldo<u32x4>(V + u2, soff); LDSET##e = ldo<u32x4>(Gt + u2, soff); \
              if (w == 0) LDSET##f = ldo<f32x4>(DCH + (size_t)((rbase >> 5) + c2) * D + cb, (unsigned)(tid & 31) * 16u); }     \
            f32x4 dch[8]; \
_Pragma("unroll") \
            for (int i = 0; i < 8; ++i) dch[i] = *(const LAS f32x4*)(B + GL_DCH + (16 * i + 4 * hh) * 4); \
            f32x4 a00 = {0.f, 0.f, 0.f, 0.f}, a01 = a00, a11 = a00; \
_Pragma("unroll") \
            for (int kk = 0; kk < 4; ++kk) { \
                const int co = (32 * kk + 8 * hh) * 2; \
                const bf16x8 k0 = *(const LAS bf16x8*)(B + GL_KD + c16 * GL_ROW + co), k1 = *(const LAS bf16x8*)(B + GL_KD + (16 + c16) * GL_ROW + co); \
                const bf16x8 q0 = *(const LAS bf16x8*)(B + GL_QS + c16 * GL_ROW + co), q1 = *(const LAS bf16x8*)(B + GL_QS + (16 + c16) * GL_ROW + co); \
                a00 = __builtin_amdgcn_mfma_f32_16x16x32_bf16(k0, q0, a00, 0, 0, 0); \
                a01 = __builtin_amdgcn_mfma_f32_16x16x32_bf16(k0, q1, a01, 0, 0, 0); \
                a11 = __builtin_amdgcn_mfma_f32_16x16x32_bf16(k1, q1, a11, 0, 0, 0); \
            } \
            if (ck > 0) GLA_NORM(ck - 1, gprev); \
            gprev = *(const LAS u32x4*)(B + GL_G + (4 * w + hh) * GL_ROW + c16 * 16); \
_Pragma("unroll") \
            for (int r = 0; r < 4; ++r) { if (4 * hh + r > c16) { a00[r] = 0.f; a11[r] = 0.f; } } \
            bf16x8 P0, P1; \
            { u32x4 t; t.x = pk2(a00[0], a00[1]); t.y = pk2(a00[2], a00[3]); t.z = 0u; t.w = 0u; P0 = __builtin_bit_cast(bf16x8, t); } \
            { u32x4 t; t.x = pk2(a01[0], a01[1]); t.y = pk2(a01[2], a01[3]); t.z = pk2(a11[0], a11[1]); t.w = pk2(a11[2], a11[3]); P1 = __builtin_bit_cast(bf16x8, t); } \
            LAS unsigned char* vp = B + GL_V + (4 * hh + q4) * GL_ROW + (16 * w + 4 * p4) * 2; \
            const bf16x8 vB = cat4(lds_tr(vp), lds_tr(vp + 16 * GL_ROW)); \
            f32x4 o0 = {0.f, 0.f, 0.f, 0.f}, o1 = o0; \
            o0 = __builtin_amdgcn_mfma_f32_16x16x32_bf16(P0, vB, o0, 0, 0, 0); \
            o1 = __builtin_amdgcn_mfma_f32_16x16x32_bf16(P1, vB, o1, 0, 0, 0); \
_Pragma("unroll") \
            for (int kk = 0; kk < 4; ++kk) { \
                u32x4 sb; sb.x = pk2(S[2 * kk][0], S[2 * kk][1]); sb.y = pk2(S[2 * kk][2], S[2 * kk][3]); sb.z = pk2(S[2 * kk + 1][0], S[2 * kk + 1][1]); sb.w = pk2(S[2 * kk + 1][2], S[2 * kk + 1][3]); \
                const bf16x8 bS = __builtin_bit_cast(bf16x8, sb); \
                const int co = (32 * kk + 4 * hh) * 2; \
                const s16x4 x0 = *(const LAS s16x4*)(B + GL_QS + c16 * GL_ROW + co), x1 = *(const LAS s16x4*)(B + GL_QS + c16 * GL_ROW + co + 32); \
                const s16x4 y0 = *(const LAS s16x4*)(B + GL_QS + (16 + c16) * GL_ROW + co), y1 = *(const LAS s16x4*)(B + GL_QS + (16 + c16) * GL_ROW + co + 32); \
                o0 = __builtin_amdgcn_mfma_f32_16x16x32_bf16(cat4(x0, x1), bS, o0, 0, 0, 0); \
                o1 = __builtin_amdgcn_mfma_f32_16x16x32_bf16(cat4(y0, y1), bS, o1, 0, 0, 0); \
            } \
            { \
                LAS unsigned char* vq = B + GL_V + (8 * hh + q4) * GL_ROW + (16 * w + 4 * p4) * 2; \
                const bf16x8 vN = cat4(lds_tr(vq), lds_tr(vq + 4 * GL_ROW)); \
_Pragma("unroll") \
                for (int i = 0; i < 8; ++i) { \
                    LAS unsigned char* kp = B + GL_KD + (8 * hh + q4) * GL_ROW + (16 * i + 4 * p4) * 2; \
                    const bf16x8 kA = cat4(lds_tr(kp), lds_tr(kp + 4 * GL_ROW)); \
                    S[i] = __builtin_amdgcn_mfma_f32_16x16x32_bf16(kA, vN, S[i], 0, 0, 0) * dch[i]; \
                } \
            } \
_Pragma("unroll") \
            for (int r = 0; r < 4; ++r) { \
                *(LAS float*)(OT + (4 * hh + r) * GL_OTROW + (16 * w + c16) * 4) = o0[r]; \
                *(LAS float*)(OT + (16 + 4 * hh + r) * GL_OTROW + (16 * w + c16) * 4) = o1[r]; \
            } \
            { \
                LAS unsigned char* dst = lds + ((ck + 1) & 1) * GL_BUF + srow * GL_ROW + sch * 16; \
                *(LAS u32x4*)(dst + GL_QS) = WRSET##a; *(LAS u32x4*)(dst + GL_KD) = WRSET##b; *(LAS u32x4*)(dst + GL_V) = WRSET##d; *(LAS u32x4*)(dst + GL_G) = WRSET##e; \
                if (tid < 32) *(LAS f32x4*)(lds + ((ck + 1) & 1) * GL_BUF + GL_DCH + tid * 16) = WRSET##f; \
            } \
            __syncthreads(); \
        } while (0)
__device__ __forceinline__ void p_gla(const Ctx& C0) {
    const Ctx C = C0;
    unsigned char* const ws_ = wsp(C); float* const out_ = outp(C);
    const bf16_t* QS = (const bf16_t*)(ws_ + WS_QS); const bf16_t* KD = (const bf16_t*)(ws_ + WS_KD);
    const bf16_t* V = (const bf16_t*)(ws_ + WS_V); const bf16_t* Gt = (const bf16_t*)(ws_ + WS_G); const float* DCH = (const float*)(ws_ + WS_DCH);
    bf16_t* O = (bf16_t*)(ws_ + WS_O); const float* gn_g = inp(C, 12); const float* S0in = inp(C, 2);
    LAS unsigned char* lds = C.lds;
    const int tid = C.tid, lane = C.lane, w = C.wave, c16 = lane & 15, hh = lane >> 4, q4 = (lane & 15) >> 2, p4 = lane & 3;
    const int srow = tid >> 4, sch = tid & 15;
    const unsigned soff = (unsigned)(srow * D + sch * 8) * 2u;
    const unsigned ooff = (unsigned)((4 * w + hh) * D + c16 * 8) * 2u;
    const unsigned stoff = (unsigned)(4 * hh * 128 + 16 * w + c16) * 4u;
    const int NPI = 128, NSI = 1024, half = C.G >= 256 ? 128 : 0;
    for (int it = 0;; ++it) {
        int item;
        if (half) { if (C.bid < half) { if (it > GLA_PROMPT_REPS - 1) break; item = C.bid; } else { item = NPI + (C.bid - half) + it * (C.G - half); if (item >= NPI + NSI) break; } }
        else { item = C.bid + it * C.G; if (item >= NPI + NSI) break; }
        int rbase, h, nck; float* Sout; const float* Sin = nullptr;
        if (item < NPI) { const int b = item >> 5; h = item & 31; rbase = b * 4096; nck = 128; Sout = out_ + OUT_SP + (size_t)item * 16384; }
        else { const int si = item - NPI, s = si >> 5; h = si & 31; rbase = MP + s * 32; nck = 1; Sout = out_ + OUT_SS + (size_t)si * 16384; Sin = S0in + (size_t)si * 16384; }
        const int cb = h * 128;
        f32x4 S[8];
#pragma unroll
        for (int i = 0; i < 8; ++i) {
            if (Sin) {
#pragma unroll
                for (int r = 0; r < 4; ++r) S[i][r] = ldo<float>(Sin + (16 * i + r) * 128, stoff);
            } else S[i] = (f32x4){0.f, 0.f, 0.f, 0.f};
        }
        __syncthreads();
        {
            const size_t u0 = (size_t)rbase * D + cb;
            const u32x4 a = ldo<u32x4>(QS + u0, soff), b = ldo<u32x4>(KD + u0, soff), d = ldo<u32x4>(V + u0, soff), e = ldo<u32x4>(Gt + u0, soff);
            LAS unsigned char* dst = lds + srow * GL_ROW + sch * 16;
            *(LAS u32x4*)(dst + GL_QS) = a; *(LAS u32x4*)(dst + GL_KD) = b; *(LAS u32x4*)(dst + GL_V) = d; *(LAS u32x4*)(dst + GL_G) = e;
            if (tid < 32) *(LAS f32x4*)(lds + GL_DCH + tid * 16) = ldo<f32x4>(DCH + (size_t)(rbase >> 5) * D + cb, (unsigned)tid * 16u);
        }
        __syncthreads();
        const f32x4 g0 = ldo<f32x4>(gn_g + cb, (unsigned)c16 * 32u), g1 = ldo<f32x4>(gn_g + cb, (unsigned)c16 * 32u + 16u);
        u32x4 RAa, RAb, RAd, RAe, RBa, RBb, RBd, RBe; f32x4 RAf = {0.f, 0.f, 0.f, 0.f}, RBf = RAf;
        { const int c1 = nck > 1 ? 1 : 0; const size_t u1 = (size_t)(rbase + 32 * c1) * D + cb; RAa = ldo<u32x4>(QS + u1, soff); RAb = ldo<u32x4>(KD + u1, soff); RAd = ldo<u32x4>(V + u1, soff); RAe = ldo<u32x4>(Gt + u1, soff);
            if (w == 0) RAf = ldo<f32x4>(DCH + (size_t)((rbase >> 5) + c1) * D + cb, (unsigned)(tid & 31) * 16u); }
        u32x4 gprev = {0u, 0u, 0u, 0u};
        for (int ck2 = 0; ck2 < nck; ck2 += 2) {
            GLA_STEP(ck2, RA, RB);
            if (ck2 + 1 < nck) GLA_STEP(ck2 + 1, RB, RA);
        }
        GLA_NORM(nck - 1, gprev);
#pragma unroll
        for (int i = 0; i < 8; ++i)
#pragma unroll
            for (int r = 0; r < 4; ++r) sto<float>(Sout + (16 * i + r) * 128, stoff, S[i][r]);
    }
    __syncthreads();
    conv_queue(C, 5, CV_S4B, CV_S5);
}
#define PHASE_FN __device__ __forceinline__ void
PHASE_FN ph_prologue() { const Ctx C = make_ctx(); p0_prologue(C); }
PHASE_FN ph_gemm_ain() {
    const Ctx C = make_ctx(); unsigned char* const ws_ = wsp(C);
    pg8::Gemm g{(const bf16_t*)(ws_ + WS_XB), (const bf16_t*)(ws_ + WS_W_AIN), M, NAIN, D}; const QueueOrder S = make_queue(C, ws_, 0, M, NAIN);
    EpiGelu E{(bf16_t*)(ws_ + WS_Z), (float*)(ws_ + WS_STAT)};
    pg8::gemm_phase<EpiGelu, QueueOrder, true, true>(C.lds, g, S, E);
    conv_queue(C, 1, CV_S1, CV_S2);
}
#ifdef PROBE_NULL
PHASE_FN ph_probe() {
    const Ctx C = make_ctx(); unsigned char* const ws_ = wsp(C); float* const out_ = outp(C);
    pg8::Gemm g{(const bf16_t*)(ws_ + WS_XB), (const bf16_t*)(ws_ + WS_W_UP0), M, NUP, D}; const QueueOrder S = make_queue(C, ws_, 4 + L, M, NUP);
#if PROBE_NULL == 1
    EpiNull E{(float*)(ws_ + WS_SLAB)};
    pg8::gemm_phase<EpiNull, pg8::StaticOrder, true, true>(C.lds, g, S, E);
#else
    EpiUpConv E{(bf16_t*)(ws_ + WS_HG), (bf16_t*)(ws_ + WS_SIDE), out_ + OUT_CP, out_ + OUT_CS, inp(C, 15), inp(C, 16)};
    pg8::gemm_phase<EpiUpConv, pg8::StaticOrder, true, true>(C.lds, g, S, E);
#endif
}
#endif
PHASE_FN ph_rowstat() { const Ctx C = make_ctx(); p_rowstat(C); }
PHASE_FN ph_spatial() { const Ctx C = make_ctx(); p_spatial(C); }
PHASE_FN ph_gemm_bin() {
    const Ctx C = make_ctx(); unsigned char* const ws_ = wsp(C);
    pg8::Gemm g{(const bf16_t*)(ws_ + WS_XB), (const bf16_t*)(ws_ + WS_W_BIN), M, NBIN, D}; const QueueOrder S = make_queue(C, ws_, 1, M, NBIN);
    EpiBin E{ws_};
    pg8::gemm_phase<EpiBin, QueueOrder, true, true>(C.lds, g, S, E);
}
PHASE_FN ph_gla() { const Ctx C = make_ctx(); p_gla(C); }
template <int L> PHASE_FN ph_gemm_out() {
    const Ctx C = make_ctx(); unsigned char* const ws_ = wsp(C);
    pg8::Gemm g{(const bf16_t*)(ws_ + (L == 0 ? WS_GATED : WS_O)), (const bf16_t*)(ws_ + (L == 0 ? WS_W_AOUT : WS_W_BOUT)), M, D, D}; const QueueOrder S = make_queue(C, ws_, 2 + L, M, D);
    EpiRes<L == 0 ? 0 : 1> E{L == 0 ? inp(C, 0) : nullptr, L == 0 ? inp(C, 1) : nullptr, (const f32x2*)(ws_ + WS_RS2), L == 0 ? nullptr : inp(C, 20), L == 0 ? nullptr : inp(C, 21), (bf16_t*)(ws_ + WS_H32), (float*)(ws_ + WS_STAT)};
    pg8::gemm_phase<EpiRes<L == 0 ? 0 : 1>, QueueOrder, true, true>(C.lds, g, S, E);
    conv_queue(C, L == 0 ? 2 : 6, L == 0 ? CV_S2 : CV_S5, L == 0 ? CV_S3 : CV_END);
}
template <int L> PHASE_FN ph_ln1() { const Ctx C = make_ctx(); unsigned char* const ws_ = wsp(C); p_ln_apply(C, inp(C, 18) + (size_t)L * D, inp(C, 19) + (size_t)L * D, (bf16_t*)(ws_ + WS_XB), nullptr); }
template <int L> PHASE_FN ph_gemm_up() {
    const Ctx C = make_ctx(); unsigned char* const ws_ = wsp(C); float* const out_ = outp(C);
    pg8::Gemm g{(const bf16_t*)(ws_ + WS_XB), (const bf16_t*)(ws_ + (L == 0 ? WS_W_UP0 : WS_W_UP1)), M, NUP, D}; const QueueOrder S = make_queue(C, ws_, 4 + L, M, NUP);
    EpiUpConv E{(bf16_t*)(ws_ + WS_HG), (bf16_t*)(ws_ + WS_SIDE), out_ + OUT_CP + (size_t)L * 4 * 2 * DFF, out_ + OUT_CS + (size_t)L * 32 * 2 * DFF, inp(C, 15) + (size_t)L * 3 * DFF, inp(C, 16) + (size_t)L * DFF};
    pg8::gemm_phase<EpiUpConv, QueueOrder, true, true>(C.lds, g, S, E);
    if (L == 0) conv_queue(C, 3, CV_S3, CV_S4);
}
template <int L> PHASE_FN ph_conv() { const Ctx C = make_ctx(); p_convfix(C, L); }
template <int L> PHASE_FN ph_gemm_dn() {
    const Ctx C = make_ctx(); unsigned char* const ws_ = wsp(C);
    pg8::Gemm g{(const bf16_t*)(ws_ + WS_HG), (const bf16_t*)(ws_ + (L == 0 ? WS_W_DN0 : WS_W_DN1)), M, D, DFF}; QueueOrder S = make_queue(C, ws_, 6 + L, M, D);
    EpiRes<1> E{nullptr, nullptr, (const f32x2*)(ws_ + WS_RS2), inp(C, 18) + (size_t)L * D, inp(C, 19) + (size_t)L * D, (bf16_t*)(ws_ + WS_H32), (float*)(ws_ + WS_STAT)};
    if (L == 1 && C.G == 256) {
        S.b.cap = 4 * 256;
        pg8::gemm_phase<EpiRes<1>, QueueOrder, true, true>(C.lds, g, S, E);
        const int kq = C.bid & 3, kt0 = kq == 0 ? 0 : (kq == 1 ? 44 : (kq == 2 ? 88 : 130)), nkt = kq < 2 ? 44 : 42;
        pg8::Gemm g2{g.A + kt0 * 64, g.Bt + kt0 * 64, M, D, nkt * 64, DFF};
        SplitOrder S2; S2.b.init(M, D, C.G, 0); S2.L = 4 * 256 + (C.bid >> 2);
        EpiPartial E2{(float*)(ws_ + WS_SLAB) + (size_t)C.bid * 65536};
        pg8::gemm_phase<EpiPartial, SplitOrder, true, true>(C.lds, g2, S2, E2);
    } else {
        pg8::gemm_phase<EpiRes<1>, QueueOrder, true, true>(C.lds, g, S, E);
        if (L == 0) conv_queue(C, 4, CV_S4, CV_S4B);
    }
}
PHASE_FN ph_dnfix() {
    const Ctx C = make_ctx(); unsigned char* const ws_ = wsp(C);
    if (C.G != 256) return;
    EpiRes<1> E{nullptr, nullptr, (const f32x2*)(ws_ + WS_RS2), inp(C, 18) + (size_t)D, inp(C, 19) + (size_t)D, (bf16_t*)(ws_ + WS_H32), (float*)(ws_ + WS_STAT)};
    pg8::StaticOrder S; S.init(M, D, C.G, 0);
    const int wr = C.wave >> 2, wc = C.wave & 3, fr = C.lane & 15, fq = C.lane >> 4;
    const unsigned t = (unsigned)(((wr * 4 + wc) * 4 + fq) * 16 + fr);
    for (int idx = C.bid >> 1; idx < 64 && C.bid < 128; idx += 64) {
        pg8::Unit u; if (!S.unit_of(4 * 256 + idx, u)) break;
        const float* slab = (const float*)(ws_ + WS_SLAB) + (size_t)idx * 4 * 65536;
        pg8::f32x4 acc[2][2][4][2];
#define DNFIX_HALF(AI) do { \
            _Pragma("unroll") for (int bj = 0; bj < 2; ++bj) _Pragma("unroll") for (int m = 0; m < 4; ++m) { \
                  \
                const unsigned o0 = ((unsigned)(((((AI) * 2 + bj) * 4 + m) * 2 + 0) * 512) + t) * 16u, o1 = o0 + 512u * 16u; \
                const pg8::f32x4 a0 = ldo<pg8::f32x4>(slab, o0), a1 = ldo<pg8::f32x4>(slab + 65536, o0), a2 = ldo<pg8::f32x4>(slab + 2 * 65536, o0), a3 = ldo<pg8::f32x4>(slab + 3 * 65536, o0); \
                const pg8::f32x4 b0 = ldo<pg8::f32x4>(slab, o1), b1 = ldo<pg8::f32x4>(slab + 65536, o1), b2 = ldo<pg8::f32x4>(slab + 2 * 65536, o1), b3 = ldo<pg8::f32x4>(slab + 3 * 65536, o1); \
                acc[AI][bj][m][0] = (a0 + a1) + (a2 + a3); acc[AI][bj][m][1] = (b0 + b1) + (b2 + b3); } \
            E.run<AI, AI + 1>(acc, u, wr, wc, fr, fq); } while (0)
        if ((C.bid & 1) == 0) DNFIX_HALF(0); else DNFIX_HALF(1);
#undef DNFIX_HALF
    }
}
template <int L> PHASE_FN ph_ln2() {
    const Ctx C = make_ctx(); unsigned char* const ws_ = wsp(C);
    p_ln_apply(C, inp(C, 20) + (size_t)L * D, inp(C, 21) + (size_t)L * D, L == 0 ? (bf16_t*)(ws_ + WS_XB) : nullptr, L == 0 ? nullptr : outp(C) + OUT_Y);
}
PHASE_FN ph_barrier() {
    const Ctx C = make_ctx();
    XcdBarrier b; b.bar = (unsigned*)(wsp(C) + WS_CTL) + CW_BAR; b.x = xb_xcc_id(); b.st = (volatile LAS unsigned*)(C.lds + MISC_OFF) + 8;
    xcd_barrier(b);
}

struct Args { const float* in[22]; float* out; unsigned char* ws; int ph_lo, ph_hi; };
static_assert(sizeof(Args) == 22 * 8 + 8 + 8 + 8, "Args has no padding");

__global__ void __launch_bounds__(512, 2) fwd_kernel(Args args) {
    LAS unsigned char* lds = (LAS unsigned char*)lds_raw;
    const int tid = threadIdx.x;
    volatile LAS unsigned* MISC = (volatile LAS unsigned*)(lds + MISC_OFF);
    if (tid < 64) MISC[tid] = 0u;
    if (tid == 64) {
        volatile LAS unsigned long long* pt = (volatile LAS unsigned long long*)(lds + PTR_OFF);
#pragma unroll
        for (int i = 0; i < 22; ++i) pt[i] = (unsigned long long)args.in[i];
        pt[22] = (unsigned long long)args.out; pt[23] = (unsigned long long)args.ws;
    }
    __syncthreads();
    if (N_LAUNCHES == 1) (void)xcd_barrier_post((unsigned*)(args.ws + WS_CTL) + CW_BAR, MISC + 8);
#ifndef REPS
#define REPS {1,1,1,1,1,1,1,1,1,1,1,1,1,1,1,1,1,1,1,1}
#endif
    constexpr int REPS_[NPHASE] = REPS;
    const int lo = args.ph_lo, hi = args.ph_hi;
#define IN(k) (lo <= (k) && (k) < hi)
#define SEAM(k) do { if (IN(k) && IN((k) + 1)) ph_barrier(); } while (0)
    if (IN(0)) { for (int r_ = 0; r_ < REPS_[0]; ++r_) ph_prologue(); }
    SEAM(0);
    if (IN(1)) { for (int r_ = 0; r_ < REPS_[1]; ++r_) ph_gemm_ain(); }

    SEAM(1);
    if (IN(2)) { for (int r_ = 0; r_ < REPS_[2]; ++r_) ph_rowstat(); }
    SEAM(2);
    if (IN(3)) { for (int r_ = 0; r_ < REPS_[3]; ++r_) ph_spatial(); }
    SEAM(3);
    if (IN(4)) { for (int r_ = 0; r_ < REPS_[4]; ++r_) ph_gemm_out<0>(); }
    SEAM(4);
    if (IN(5)) { for (int r_ = 0; r_ < REPS_[5]; ++r_) ph_ln1<0>(); }
    SEAM(5);
    if (IN(6)) { for (int r_ = 0; r_ < REPS_[6]; ++r_) ph_gemm_up<0>(); }
#ifdef PROBE_NULL
    if (IN(6)) { ph_barrier(); ph_probe(); }
#endif
    SEAM(6);
    if (IN(7)) { for (int r_ = 0; r_ < REPS_[7]; ++r_) ph_conv<0>(); }
    SEAM(7);
    if (IN(8)) { for (int r_ = 0; r_ < REPS_[8]; ++r_) ph_gemm_dn<0>(); }
    SEAM(8);
    if (IN(9)) { for (int r_ = 0; r_ < REPS_[9]; ++r_) ph_ln2<0>(); }
    SEAM(9);
    if (IN(10)) { for (int r_ = 0; r_ < REPS_[10]; ++r_) ph_gemm_bin(); }
    SEAM(10);
    if (IN(12)) { for (int r_ = 0; r_ < REPS_[12]; ++r_) ph_gla(); }
    SEAM(12);
    if (IN(13)) { for (int r_ = 0; r_ < REPS_[13]; ++r_) ph_gemm_out<1>(); }
    SEAM(13);
    if (IN(14)) { for (int r_ = 0; r_ < REPS_[14]; ++r_) ph_ln1<1>(); }
    SEAM(14);
    if (IN(15)) { for (int r_ = 0; r_ < REPS_[15]; ++r_) ph_gemm_up<1>(); }
    SEAM(15);
    if (IN(16)) { for (int r_ = 0; r_ < REPS_[16]; ++r_) ph_conv<1>(); }
    SEAM(16);
    if (IN(17)) { for (int r_ = 0; r_ < REPS_[17]; ++r_) ph_gemm_dn<1>(); }
    SEAM(17);
    if (IN(18)) { for (int r_ = 0; r_ < REPS_[18]; ++r_) ph_dnfix(); }
    SEAM(18);
    if (IN(19)) { for (int r_ = 0; r_ < REPS_[19]; ++r_) ph_ln2<1>(); }
#undef IN
#undef SEAM
}

#ifdef DBG_STOP
__global__ void dbg_fold(const unsigned* src, size_t n_words, float* out, size_t n_out) {
    for (size_t j = (size_t)blockIdx.x * blockDim.x + threadIdx.x; j < n_out; j += (size_t)gridDim.x * blockDim.x) {
        unsigned acc = 0u; for (size_t i = j; i < n_words; i += n_out) acc ^= src[i];
        acc ^= acc >> 16; acc ^= acc >> 8; out[j] = (float)(acc & 0xffu);
    }
}
#endif
extern "C" void kernel_launch(void* const* d_in, const int* in_sizes, int n_in, void* d_out, int out_size, void* d_ws, size_t ws_size, hipStream_t stream) {
    static int grid = 0;
    if (grid == 0) {
        if (n_in != 22 || (size_t)out_size != OUT_END || ws_size < WS_END) { fprintf(stderr, "kernel_launch: unexpected shapes (n_in %d, out %d, ws %zu)\n", n_in, out_size, ws_size); grid = -1; return; }
        int dev = 0, cus = 0;
        if (hipGetDevice(&dev) != hipSuccess || hipDeviceGetAttribute(&cus, hipDeviceAttributeMultiprocessorCount, dev) != hipSuccess) { grid = -1; return; }
        if (hipFuncSetAttribute((const void*)fwd_kernel, hipFuncAttributeMaxDynamicSharedMemorySize, LDS_BYTES) != hipSuccess) { fprintf(stderr, "kernel_launch: hipFuncSetAttribute failed\n"); grid = -1; return; }
        int per_cu = 0;
        if (hipOccupancyMaxActiveBlocksPerMultiprocessor(&per_cu, (const void*)fwd_kernel, 512, LDS_BYTES) != hipSuccess || per_cu < 1) fprintf(stderr, "kernel_launch: occupancy query says %d\n", per_cu);
        (void)hipGetLastError();
        grid = cus;
    }
    if (grid < 0) return;
    (void)hipMemsetAsync((char*)d_ws + WS_CTL, 0, CTL_BYTES, stream);
    Args a{};
    for (int i = 0; i < 22; ++i) a.in[i] = (const float*)d_in[i];
    a.out = (float*)d_out; a.ws = (unsigned char*)d_ws;
    if (N_LAUNCHES == 1) { a.ph_lo = 0; a.ph_hi = NPHASE; hipLaunchKernelGGL(fwd_kernel, dim3(grid), dim3(512), LDS_BYTES, stream, a); }
    else for (int p = 0; p < NPHASE; ++p) {
#ifdef DBG_STOP
        if (p > DBG_STOP) break;
#endif
        a.ph_lo = p; a.ph_hi = p + 1; hipLaunchKernelGGL(fwd_kernel, dim3(grid), dim3(512), LDS_BYTES, stream, a); }
#ifdef DBG_STOP
    hipLaunchKernelGGL(dbg_fold, dim3(2048), dim3(256), 0, stream, (const unsigned*)((const char*)d_ws + (size_t)(DBG_OFF)), (size_t)(DBG_BYTES) / 4, (float*)d_out, (size_t)out_size);
#endif
}
```

```cpp
#include <hip/hip_runtime.h>
#include <cstdio>
#include <cstdint>
#define LAS __attribute__((address_space(3)))
#define GAS __attribute__((address_space(1)))
#define N_LAUNCHES 1

namespace pg8 {
#define PG8_LAS __attribute__((address_space(3)))
typedef unsigned short bf16_t;
typedef short bf16x8 __attribute__((ext_vector_type(8)));
typedef float f32x4 __attribute__((ext_vector_type(4)));
typedef unsigned u32x4 __attribute__((ext_vector_type(4)));
constexpr int BM = 256, BK = 64, HALF = 128, HTB = HALF * BK * 2  , STAGE_BYTES = 8 * HTB, NXCD = 8, WGM = 8;

__host__ __device__ __forceinline__ int lds_byte(int r, int c) { const int st = (r >> 4) * 2 + (c >> 5), rr = r & 15, cc = c & 31, ob = rr * 64 + cc * 2; return st * 1024 + (ob ^ (((ob >> 9) & 1) << 5)); }
__host__ __device__ __forceinline__ void stage_rc(int b, int& R, int& C) { const int st = b / 1024, sb = b % 1024, swz = sb ^ (((sb >> 9) & 1) << 5); R = (st >> 1) * 16 + swz / 64; C = (st & 1) * 32 + (swz % 64) / 2; }
__host__ __device__ __forceinline__ int perm32(int rho) { const int n = rho >> 4, i = rho & 15; return 8 * (i >> 2) + 4 * n + (i & 3); }

struct Unit { int pm, pn; };
struct Gemm { const bf16_t* A; const bf16_t* Bt; int M, N, K, P; };

struct StaticOrder {
    int nM, nN, nwg, G, c, cap;
    __host__ __device__ void init(int M, int N, int G_, int c_) { nM = M / BM; nN = N / BM; nwg = nM * nN; G = G_; c = c_; cap = nwg; }
    __host__ __device__ bool next(int i, Unit& u) const { return unit_of((long)i * G + c, u); }
    __host__ __device__ bool unit_of(long L, Unit& u) const {
        if (L >= cap) return false;
        int wgid = (int)L;
        { const int nig0 = WGM * nN, rem = nwg - NXCD * nig0;
          if (nM / WGM == NXCD && rem >= 0 && rem % NXCD == 0) {
              const int x = wgid % NXCD, t = wgid / NXCD, rem8 = rem / NXCD;
              wgid = t < nig0 ? x * nig0 + t : NXCD * nig0 + x * rem8 + (t - nig0);
          } else { const int q = nwg / NXCD, r = nwg % NXCD, xcd = wgid % NXCD, off = wgid / NXCD; wgid = (xcd < r ? xcd * (q + 1) : r * (q + 1) + (xcd - r) * q) + off; } }
        const int nig = WGM * nN, gid = wgid / nig, fm = gid * WGM, gsz = (nM - fm) < WGM ? (nM - fm) : WGM;
        u.pm = fm + ((wgid % nig) % gsz); u.pn = (wgid % nig) / gsz; return true;
    }
    __device__ __forceinline__ void a_ready(const Unit&) const {}
    __device__ __forceinline__ void done(const Unit&) const {}
    __device__ __forceinline__ int issue(int, int, int) const { return 0; }
    __device__ __forceinline__ bool resolve(int, int i, Unit& u, int, int) const { return next(i, u); }
};

__device__ __forceinline__ unsigned cvt_pk_bf16(float lo, float hi) { unsigned r; asm volatile("v_cvt_pk_bf16_f32 %0, %1, %2" : "=v"(r) : "v"(lo), "v"(hi)); return r; }
template <class Epi, class Sched, bool ALIGN_EPI = false, bool SP2 = false>
__device__ __forceinline__ void gemm_phase(PG8_LAS unsigned char* lds, const Gemm g, const Sched& S, const Epi& E) {
    int tid_ = threadIdx.x; asm volatile("" : "+v"(tid_));
    const int tid = tid_, wid = __builtin_amdgcn_readfirstlane(tid >> 6), lane = tid & 63, wr = wid >> 2, wc = wid & 3, fr = lane & 15, fq = lane >> 4;
    const int nt = g.K / BK, K = g.P ? g.P : g.K;
    unsigned voffA[2], voffB[2];
#pragma unroll
    for (int i = 0; i < 2; ++i) { int R, C; stage_rc(tid * 16 + i * 8192, R, C); const int Rb = Epi::PERM ? ((R & ~31) + perm32(R & 31)) : R;
        voffA[i] = (unsigned)(R * K + C) * 2u; voffB[i] = (unsigned)(Rb * K + C) * 2u; }
    const size_t kstep = (size_t)(BK * 2);
    const size_t hstep = (size_t)HALF * K * 2;
    const size_t tstep = 2 * hstep;
    const unsigned ldsw = (unsigned)wid * 1024u;
    const int aoff = lds_byte(wr * 64 + fr, fq * 8), boff = lds_byte(wc * 32 + fr, fq * 8);
#define PG8_SA(b, h) (((b) * 2 + (h)) * HTB)
#define PG8_SB(b, h) ((4 + (b) * 2 + (h)) * HTB)
#define PG8_STAGE(bufoff, gbase, voff) do { _Pragma("unroll") for (int _i = 0; _i < 2; ++_i) \
        __builtin_amdgcn_global_load_lds((const unsigned*)((const char*)(gbase) + (voff)[_i]), (PG8_LAS unsigned*)(lds + (bufoff) + ldsw + _i * 8192), 16, 0, 0); } while (0)
#define PG8_LDA(dst, b, h) do { _Pragma("unroll") for (int m = 0; m < 4; ++m) _Pragma("unroll") for (int k = 0; k < 2; ++k) dst[m][k] = *(const PG8_LAS bf16x8*)(lds + PG8_SA(b, h) + aoff + m * 2048 + k * 1024); } while (0)
#define PG8_LDB(dst, b, h) do { _Pragma("unroll") for (int n = 0; n < 2; ++n) _Pragma("unroll") for (int k = 0; k < 2; ++k) dst[n][k] = *(const PG8_LAS bf16x8*)(lds + PG8_SB(b, h) + boff + n * 2048 + k * 1024); } while (0)
#define PG8_MMA(ai, bj, At, Bt) do { __builtin_amdgcn_s_setprio(1); _Pragma("unroll") for (int m = 0; m < 4; ++m) _Pragma("unroll") for (int n = 0; n < 2; ++n) _Pragma("unroll") for (int k = 0; k < 2; ++k) \
        acc[ai][bj][m][n] = __builtin_amdgcn_mfma_f32_16x16x32_bf16(Bt[n][k], At[m][k], acc[ai][bj][m][n], 0, 0, 0); __builtin_amdgcn_s_setprio(0); } while (0)
#define PG8_WAIT_V(n) asm volatile("s_waitcnt vmcnt(" #n ")" ::: "memory")
#define PG8_WAIT_L(n) asm volatile("s_waitcnt lgkmcnt(" #n ")" ::: "memory")
#define PG8_BAR __builtin_amdgcn_s_barrier()
#define PG8_SCHED __builtin_amdgcn_sched_barrier(0)
    Unit cur, nxt; int ui = 0;
    { const int tk0 = S.issue(0, wid, lane); if (!S.resolve(tk0, 0, cur, wid, lane)) return; }
    f32x4 acc[2][2][4][2];
#pragma unroll
    for (int a = 0; a < 2; ++a)
#pragma unroll
        for (int b = 0; b < 2; ++b)
#pragma unroll
            for (int m = 0; m < 4; ++m)
#pragma unroll
                for (int n = 0; n < 2; ++n) acc[a][b][m][n] = (f32x4){0.f, 0.f, 0.f, 0.f};
    bf16x8 At[4][2], B0[2][2], B1[2][2];
    const char* cA = (const char*)g.A + (size_t)cur.pm * tstep; const char* cB = (const char*)g.Bt + (size_t)cur.pn * tstep;
    S.a_ready(cur);
    if constexpr (SP2) {
        PG8_STAGE(PG8_SB(0, 0), cB, voffB); PG8_STAGE(PG8_SB(0, 1), cB + hstep, voffB); PG8_STAGE(PG8_SA(0, 0), cA, voffA); PG8_STAGE(PG8_SA(0, 1), cA + hstep, voffA);
        if (wr == 1) PG8_BAR;
        PG8_WAIT_V(2); PG8_BAR;
        PG8_STAGE(PG8_SB(1, 0), cB + kstep, voffB); PG8_STAGE(PG8_SA(1, 0), cA + kstep, voffA); PG8_STAGE(PG8_SB(1, 1), cB + hstep + kstep, voffB);
        PG8_WAIT_V(6); PG8_BAR;
    } else {
        PG8_STAGE(PG8_SB(0, 0), cB, voffB); PG8_STAGE(PG8_SA(0, 0), cA, voffA); PG8_STAGE(PG8_SB(0, 1), cB + hstep, voffB); PG8_STAGE(PG8_SA(0, 1), cA + hstep, voffA);
        if (wr == 1) PG8_BAR;
        PG8_WAIT_V(4); PG8_BAR;
        PG8_STAGE(PG8_SB(1, 0), cB + kstep, voffB); PG8_STAGE(PG8_SA(1, 0), cA + kstep, voffA); PG8_STAGE(PG8_SB(1, 1), cB + hstep + kstep, voffB);
        PG8_WAIT_V(6); PG8_BAR;
    }
    for (;;) {
        const int tk = S.issue(ui + 1, wid, lane);
        bool has_next = false;
        const char* nA = cA; const char* nB = cB;
        for (int t = 0; t < nt; t += 2) {
            const bool last = (t == nt - 2);
            if (last) { has_next = S.resolve(tk, ui + 1, nxt, wid, lane); if (has_next) { nA = (const char*)g.A + (size_t)nxt.pm * tstep; nB = (const char*)g.Bt + (size_t)nxt.pn * tstep; } }
            const char* a1 = cA + (size_t)(t + 1) * kstep;
            const char* a2 = last ? nA : cA + (size_t)(t + 2) * kstep; const char* b2 = last ? nB : cB + (size_t)(t + 2) * kstep;
            const char* a3 = a2 + kstep; const char* b3 = b2 + kstep;
            if (last && has_next) S.a_ready(nxt);
            if constexpr (SP2) {
            PG8_LDB(B0, 0, 0); PG8_LDB(B1, 0, 1); PG8_SCHED; PG8_LDA(At, 0, 0); PG8_STAGE(PG8_SA(1, 1), a1 + hstep, voffA);
            PG8_WAIT_V(8); PG8_WAIT_L(0); PG8_BAR; PG8_MMA(0, 0, At, B0); PG8_MMA(0, 1, At, B1); PG8_BAR; PG8_SCHED;
            PG8_LDA(At, 0, 1); PG8_STAGE(PG8_SB(0, 0), b2, voffB); PG8_STAGE(PG8_SB(0, 1), b2 + hstep, voffB); PG8_STAGE(PG8_SA(0, 0), a2, voffA);
            PG8_WAIT_V(8); PG8_WAIT_L(0); PG8_BAR; PG8_MMA(1, 0, At, B0); PG8_MMA(1, 1, At, B1); PG8_BAR; PG8_SCHED;
            PG8_LDB(B0, 1, 0); PG8_LDB(B1, 1, 1); PG8_SCHED; PG8_LDA(At, 1, 0); PG8_STAGE(PG8_SA(0, 1), a2 + hstep, voffA);
            PG8_WAIT_V(8); PG8_WAIT_L(0); PG8_BAR; PG8_MMA(0, 0, At, B0); PG8_MMA(0, 1, At, B1); PG8_BAR; PG8_SCHED;
            PG8_LDA(At, 1, 1); PG8_STAGE(PG8_SB(1, 0), b3, voffB); PG8_STAGE(PG8_SB(1, 1), b3 + hstep, voffB); PG8_STAGE(PG8_SA(1, 0), a3, voffA);
            PG8_WAIT_V(8); PG8_WAIT_L(0); PG8_BAR; PG8_MMA(1, 0, At, B0); PG8_MMA(1, 1, At, B1); PG8_BAR; PG8_SCHED;
            } else {
            PG8_LDB(B0, 0, 0); PG8_SCHED; PG8_LDA(At, 0, 0); PG8_STAGE(PG8_SA(1, 1), a1 + hstep, voffA);
            PG8_WAIT_L(8); PG8_BAR; PG8_WAIT_L(0); PG8_MMA(0, 0, At, B0); PG8_BAR; PG8_SCHED;
            PG8_LDB(B1, 0, 1); PG8_STAGE(PG8_SB(0, 0), b2, voffB);
            PG8_BAR; PG8_WAIT_L(0); PG8_MMA(0, 1, At, B1); PG8_BAR;
            PG8_LDA(At, 0, 1); PG8_STAGE(PG8_SA(0, 0), a2, voffA);
            PG8_BAR; PG8_WAIT_L(0); PG8_MMA(1, 0, At, B0); PG8_BAR; PG8_SCHED;
            PG8_STAGE(PG8_SB(0, 1), b2 + hstep, voffB);
            PG8_WAIT_V(6); PG8_BAR; PG8_MMA(1, 1, At, B1); PG8_BAR;
            PG8_LDB(B0, 1, 0); PG8_SCHED; PG8_LDA(At, 1, 0); PG8_STAGE(PG8_SA(0, 1), a2 + hstep, voffA);
            PG8_WAIT_L(8); PG8_BAR; PG8_WAIT_L(0); PG8_MMA(0, 0, At, B0); PG8_BAR; PG8_SCHED;
            PG8_LDB(B1, 1, 1); PG8_STAGE(PG8_SB(1, 0), b3, voffB);
            PG8_BAR; PG8_WAIT_L(0); PG8_MMA(0, 1, At, B1); PG8_BAR;
            PG8_LDA(At, 1, 1); PG8_STAGE(PG8_SA(1, 0), a3, voffA);
            PG8_BAR; PG8_WAIT_L(0); PG8_MMA(1, 0, At, B0); PG8_BAR; PG8_SCHED;
            PG8_STAGE(PG8_SB(1, 1), b3 + hstep, voffB);
            PG8_WAIT_V(6); PG8_BAR; PG8_MMA(1, 1, At, B1); PG8_BAR;
            }
        }
        if constexpr (ALIGN_EPI) { if (wr == 0) PG8_BAR; }
        if constexpr (!Epi::AFTER_DRAIN) { E(acc, cur, wr, wc, fr, fq); S.done(cur); }
        if (!has_next) break;
#pragma unroll
        for (int a = 0; a < 2; ++a)
#pragma unroll
            for (int b = 0; b < 2; ++b)
#pragma unroll
                for (int m = 0; m < 4; ++m)
#pragma unroll
                    for (int n = 0; n < 2; ++n) acc[a][b][m][n] = (f32x4){0.f, 0.f, 0.f, 0.f};
        cur = nxt; cA = nA; cB = nB; ++ui;
        if constexpr (ALIGN_EPI) { if (wr == 1) PG8_BAR; }
    }
    PG8_WAIT_V(0);
    if constexpr (!ALIGN_EPI) { if (wr == 0) PG8_BAR; }
    PG8_BAR;
    if constexpr (Epi::AFTER_DRAIN) { E.fused(acc, cur, wr, wc, fr, fq, lds, wid, lane); S.done(cur); }
#undef PG8_SA
#undef PG8_SB
#undef PG8_STAGE
#undef PG8_LDA
#undef PG8_LDB
#undef PG8_MMA
#undef PG8_WAIT_V
#undef PG8_WAIT_L
#undef PG8_BAR
#undef PG8_SCHED
}
}
#define XB_TMO      128
#define XB_XCNT(j)  (256  + 64 * (j))
#define XB_XSUB(j)  (1280 + 64 * (j))
#define XB_XGEN(j)  (2304 + 64 * (j))
#define XB_TOP      3328
#define XB_TOPGEN   3392
#define XCD_BAR_WORDS 3456
#define XB_SPIN_CAP (1u << 18)

__device__ __forceinline__ unsigned xb_ld(unsigned* p)              { return __hip_atomic_load(p, __ATOMIC_RELAXED, __HIP_MEMORY_SCOPE_AGENT); }
__device__ __forceinline__ unsigned xb_add(unsigned* p, unsigned v) { return __hip_atomic_fetch_add(p, v, __ATOMIC_RELAXED, __HIP_MEMORY_SCOPE_AGENT); }
__device__ __forceinline__ unsigned xb_xcc_id() { return (unsigned)__builtin_amdgcn_s_getreg((3 << 11) | 20) & 0xFu; }
#define XB_SPIN(cond, bar) do { unsigned _sp = 0; while (cond) { __builtin_amdgcn_s_sleep(1); \
    if ((++_sp & 255u) == 0u) { if (xb_ld(&(bar)[XB_TMO])) break; if (_sp > XB_SPIN_CAP) { atomicAdd(&(bar)[XB_TMO], 1u); break; } } } } while (0)

struct XcdBarrier {
    unsigned* bar; unsigned x;
    volatile LAS unsigned* st;
};

__device__ __forceinline__ XcdBarrier xcd_barrier_post(unsigned* bar, volatile LAS unsigned* st) {
    XcdBarrier b; b.bar = bar; b.x = xb_xcc_id(); b.st = st;
    if (threadIdx.x == 0) (void)xb_add(&bar[XB_XCNT(b.x)], 1u);
    return b;
}
__device__ __forceinline__ void xcd_barrier_complete(unsigned* bar, unsigned x, unsigned& nloc, unsigned& nx) {
    const unsigned G = gridDim.x * gridDim.y * gridDim.z;
    unsigned sum, cnt, mine, sp = 0u;
    for (;;) {
        sum = 0u; cnt = 0u; mine = 0u;
#pragma unroll
        for (unsigned j = 0; j < 16; ++j) { const unsigned c = xb_ld(&bar[XB_XCNT(j)]); sum += c; cnt += (c > 0u) ? 1u : 0u; mine = (j == x) ? c : mine; }
        if (sum == G) break;
        __builtin_amdgcn_s_sleep(1);
        if ((++sp & 255u) == 0u) { if (xb_ld(&bar[XB_TMO])) break; if (sp > XB_SPIN_CAP) { atomicAdd(&bar[XB_TMO], 1u); break; } }
    }
    nloc = mine > 0u ? mine : 1u; nx = cnt > 0u ? cnt : 1u;
}

__device__ __forceinline__ void xcd_barrier(const XcdBarrier& b) {
    asm volatile("s_waitcnt vmcnt(0)" ::: "memory");
    __syncthreads();
    if (threadIdx.x == 0) {
        unsigned* bar = b.bar;
        __builtin_amdgcn_s_waitcnt(0);
        unsigned nloc = b.st[0], nx = b.st[1];
        if (nloc == 0u) { xcd_barrier_complete(bar, b.x, nloc, nx); b.st[0] = nloc; b.st[1] = nx; }
        const unsigned old = xb_add(&bar[XB_XSUB(b.x)], 1u);
        const unsigned gen = old / nloc;
        if (old + 1u == (gen + 1u) * nloc) {
            __builtin_amdgcn_fence(__ATOMIC_RELEASE, "agent");
            asm volatile("s_waitcnt vmcnt(0)" ::: "memory");
            const unsigned og = xb_add(&bar[XB_TOP], 1u);
            const unsigned tg = og / nx;
            if (og + 1u == (tg + 1u) * nx) xb_add(&bar[XB_TOPGEN], 1u);
            else XB_SPIN(xb_ld(&bar[XB_TOPGEN]) == tg, bar);
            __builtin_amdgcn_fence(__ATOMIC_ACQUIRE, "agent");
            xb_add(&bar[XB_XGEN(b.x)], 1u);
            asm volatile("s_waitcnt vmcnt(0)" ::: "memory");
        } else {
            XB_SPIN(xb_ld(&bar[XB_XGEN(b.x)]) == gen, bar);
            __builtin_amdgcn_fence(__ATOMIC_ACQUIRE, "agent");
            asm volatile("s_waitcnt vmcnt(0)" ::: "memory");
        }
    }
    __syncthreads();
}
#ifndef N_LAUNCHES
#define N_LAUNCHES 1
#endif
constexpr int MP = 16384, MS = 1024, M = MP + MS, D = 4096, DFF = 11008, NUP = 2 * DFF, NAIN = 8192, NBIN = 16384;
constexpr int NPHASE = 20;
constexpr float ALPHA = 1.41421356237309515f, LN_EPS = 1e-5f, RMS_EPS = 1e-6f;
typedef unsigned short bf16_t;
typedef float f32x4 __attribute__((ext_vector_type(4)));
typedef float f32x2 __attribute__((ext_vector_type(2)));
typedef unsigned u32x4 __attribute__((ext_vector_type(4)));
typedef unsigned u32x2 __attribute__((ext_vector_type(2)));
typedef short bf16x8 __attribute__((ext_vector_type(8)));
typedef short s16x4 __attribute__((ext_vector_type(4)));

constexpr size_t MiB = 1u << 20;
constexpr size_t WS_CTL = 0, CTL_BYTES = 1 * MiB;
constexpr size_t WS_W_AIN = 1 * MiB;
constexpr size_t WS_W_AOUT = WS_W_AIN + 64 * MiB;
constexpr size_t WS_W_UP0 = WS_W_AOUT + 32 * MiB;
constexpr size_t WS_W_DN0 = WS_W_UP0 + 172 * MiB;
constexpr size_t WS_W_BIN = WS_W_DN0 + 86 * MiB;
constexpr size_t WS_W_BOUT = WS_W_BIN + 128 * MiB;
constexpr size_t WS_W_UP1 = WS_W_BOUT + 32 * MiB;
constexpr size_t WS_W_DN1 = WS_W_UP1 + 172 * MiB;
constexpr size_t WS_XB = WS_W_DN1 + 86 * MiB;
constexpr size_t WS_X32 = WS_XB + 136 * MiB;
constexpr size_t WS_H32 = WS_X32 + 272 * MiB;
constexpr size_t WS_STAT = WS_H32 + 272 * MiB;
constexpr size_t WS_ROWSTAT = WS_STAT + 9 * MiB;
constexpr size_t WS_LB = WS_ROWSTAT + 512 * 1024;
constexpr size_t WS_RS2 = WS_ROWSTAT + 768 * 1024;
constexpr size_t WS_BIG = WS_ROWSTAT + 1 * MiB;
constexpr size_t WS_Z = WS_BIG;
constexpr size_t WS_GATED = WS_BIG + 272 * MiB;
constexpr size_t WS_SIDE = WS_BIG;
constexpr size_t WS_HG = WS_BIG + 731 * MiB;
constexpr size_t WS_Q = WS_BIG;
constexpr size_t WS_ZF = WS_BIG + 136 * MiB;
constexpr size_t WS_V = WS_BIG + 272 * MiB;
constexpr size_t WS_G = WS_BIG + 408 * MiB;
constexpr size_t WS_O = WS_BIG + 816 * MiB;
constexpr size_t WS_DCH = WS_BIG + 952 * MiB;
constexpr size_t WS_QS = WS_X32;
constexpr size_t WS_KD = WS_X32 + 136 * MiB;
constexpr size_t WS_SLAB = WS_BIG + 128 * MiB;
constexpr size_t WS_END = WS_BIG + 1097 * MiB;
static_assert(WS_HG + (size_t)M * DFF * 2 <= WS_END && WS_DCH + (size_t)(M / 32) * D * 4 <= WS_END, "ws map");
constexpr size_t OUT_Y = 0, OUT_NV = (size_t)M * D, OUT_SP = OUT_NV + (size_t)MS * D, OUT_SS = OUT_SP + (size_t)4 * 32 * 128 * 128,
                 OUT_CP = OUT_SS + (size_t)32 * 32 * 128 * 128, OUT_CS = OUT_CP + (size_t)2 * 4 * 2 * DFF, OUT_END = OUT_CS + (size_t)2 * 32 * 2 * DFF;
constexpr int LDS_BYTES = 163840, MISC_OFF = LDS_BYTES - 256, PTR_OFF = LDS_BYTES - 512;
constexpr int CW_BAR = 4096;

__device__ __forceinline__ float bf2f(unsigned b16) { return __uint_as_float(b16 << 16); }
typedef __bf16 bf16x2_t __attribute__((ext_vector_type(2)));
__device__ __forceinline__ unsigned pk2(float lo, float hi) { const f32x2 v = {lo, hi}; const bf16x2_t b = __builtin_convertvector(v, bf16x2_t); return __builtin_bit_cast(unsigned, b); }
__device__ __forceinline__ float bflo(unsigned w) { return __uint_as_float(w << 16); }
__device__ __forceinline__ float bfhi(unsigned w) { return __uint_as_float(w & 0xffff0000u); }
__device__ __forceinline__ float wave_sum(float v) {
#pragma unroll
    for (int o = 1; o < 64; o <<= 1) v += __shfl_xor(v, o);
    return v;
}
__device__ __forceinline__ float fexp(float x) { return __builtin_amdgcn_exp2f(x * 1.44269504088896341f); }
__device__ __forceinline__ float frcp(float x) { return __builtin_amdgcn_rcpf(x); }
__device__ __forceinline__ float fsigmoid(float x) { return frcp(1.0f + fexp(-x)); }
__device__ __forceinline__ float fsilu(float x) { return x * fsigmoid(x); }
__device__ __forceinline__ float fgelu_tanh(float x) {
    const float t = x * (1.5957691216057308f + 0.07135481627f * x * x);
    return x * frcp(1.0f + fexp(-t));
}
__device__ __forceinline__ s16x4 lds_tr(LAS unsigned char* p) { return __builtin_amdgcn_ds_read_tr16_b64_v4i16((LAS s16x4*)p); }
__device__ __forceinline__ bf16x8 cat4(s16x4 a, s16x4 b) { return (bf16x8){a[0], a[1], a[2], a[3], b[0], b[1], b[2], b[3]}; }
template <class T> __device__ __forceinline__ T ldo(const void* ubase, unsigned boff) { return *(const T*)((const char*)ubase + boff); }
template <class T> __device__ __forceinline__ void sto(void* ubase, unsigned boff, T v) { *(T*)((char*)ubase + boff) = v; }
#define LDS_WAIT() asm volatile("s_waitcnt lgkmcnt(0)" ::: "memory")
#define VM_WAIT() asm volatile("s_waitcnt vmcnt(0)" ::: "memory")

struct Ctx {
    LAS unsigned char* lds;
    int tid, lane, wave, G, bid;
};
extern __shared__ __attribute__((aligned(16))) unsigned char lds_raw[];
__device__ __forceinline__ Ctx make_ctx() {
    Ctx C; C.lds = (LAS unsigned char*)lds_raw; int t = threadIdx.x; asm volatile("" : "+v"(t));
    C.tid = t; C.lane = t & 63; C.wave = __builtin_amdgcn_readfirstlane(t >> 6); C.G = gridDim.x; C.bid = blockIdx.x; return C;
}
__device__ __forceinline__ unsigned long long ptab(const Ctx& C, int k) {
    const unsigned lo = *(volatile LAS unsigned*)(C.lds + PTR_OFF + 8 * k), hi = *(volatile LAS unsigned*)(C.lds + PTR_OFF + 8 * k + 4);
    return ((unsigned long long)(unsigned)__builtin_amdgcn_readfirstlane((int)hi) << 32) | (unsigned)__builtin_amdgcn_readfirstlane((int)lo);
}
__device__ __forceinline__ const float* inp(const Ctx& C, int k) { return (const float*)(GAS const float*)ptab(C, k); }
__device__ __forceinline__ float* outp(const Ctx& C) { return (float*)(GAS float*)ptab(C, 22); }
__device__ __forceinline__ unsigned char* wsp(const Ctx& C) { return (unsigned char*)(GAS unsigned char*)ptab(C, 23); }
__device__ __forceinline__ const float* xin_row(const float* xp, const float* xs, int row) { return row < MP ? xp + (size_t)row * D : xs + (size_t)(row - MP) * D; }

struct EpiGelu {
    static constexpr bool PERM = true, AFTER_DRAIN = false;
    bf16_t* Z; float* stat;
    __device__ __forceinline__ void operator()(const pg8::f32x4 (&acc)[2][2][4][2], const pg8::Unit& u, int wr, int wc, int fr, int fq) const {
        const int row0 = u.pm * 256 + wr * 64 + fr, col0 = u.pn * 256 + wc * 32 + 8 * fq;
        const bool isv = u.pn >= 16;
#pragma unroll
        for (int ai = 0; ai < 2; ++ai)
#pragma unroll
            for (int m = 0; m < 4; ++m) {
                const int row = row0 + ai * 128 + m * 16; float s1 = 0.f, s2 = 0.f;
#pragma unroll
                for (int bj = 0; bj < 2; ++bj) {
                    float z[8];
#pragma unroll
                    for (int j = 0; j < 4; ++j) { z[j] = fgelu_tanh(acc[ai][bj][m][0][j]); z[4 + j] = fgelu_tanh(acc[ai][bj][m][1][j]); }
#pragma unroll
                    for (int j = 0; j < 8; ++j) { s1 += z[j]; s2 += z[j] * z[j]; }
                    u32x4 w; w.x = pk2(z[0], z[1]); w.y = pk2(z[2], z[3]); w.z = pk2(z[4], z[5]); w.w = pk2(z[6], z[7]);
                    *(u32x4*)(Z + (size_t)row * NAIN + col0 + bj * 128) = w;
                }
                if (isv) {
                    s1 += __shfl_xor(s1, 16); s1 += __shfl_xor(s1, 32); s2 += __shfl_xor(s2, 16); s2 += __shfl_xor(s2, 32);
                    if (fq == 0) *(f32x2*)(stat + ((size_t)row * 64 + (u.pn - 16) * 4 + wc) * 2) = (f32x2){s1, s2};
                }
            }
    }
};
template <int MODE> struct EpiRes {
    static constexpr bool PERM = true, AFTER_DRAIN = false;
    const float* xa; const float* xb; const f32x2* rs; const float* lng; const float* lnb;
    bf16_t* H; float* stat;
    __device__ __forceinline__ void operator()(const pg8::f32x4 (&acc)[2][2][4][2], const pg8::Unit& u, int wr, int wc, int fr, int fq) const { run<0, 2>(acc, u, wr, wc, fr, fq); }
    template <int AI0, int AI1> __device__ __forceinline__ void run(const pg8::f32x4 (&acc)[2][2][4][2], const pg8::Unit& u, int wr, int wc, int fr, int fq) const {
        const int row0 = u.pm * 256 + wr * 64 + fr, col0 = u.pn * 256 + wc * 32 + 8 * fq;
        const float* xbase = nullptr;
        if (MODE == 0) xbase = (u.pm < MP / 256) ? xa + (size_t)row0 * D : xb + (size_t)(row0 - MP) * D;
        float s1[8], s2[8];
#pragma unroll
        for (int i = 0; i < 8; ++i) { s1[i] = 0.f; s2[i] = 0.f; }
#pragma unroll
        for (int bj = 0; bj < 2; ++bj) {
            f32x4 g0, g1, b0, b1;
            if (MODE == 1) { const float* gp = lng + col0 + bj * 128; const float* bp = lnb + col0 + bj * 128; g0 = *(const f32x4*)gp; g1 = *(const f32x4*)(gp + 4); b0 = *(const f32x4*)bp; b1 = *(const f32x4*)(bp + 4); }
#pragma unroll
            for (int ai = AI0; ai < AI1; ++ai)
#pragma unroll
                for (int m = 0; m < 4; ++m) {
                    const int ro = ai * 128 + m * 16;
                    bf16_t* hp = H + (size_t)(row0 + ro) * D + col0 + bj * 128;
                    f32x4 x0, x1;
                    if (MODE == 0) { const float* xp = xbase + (size_t)ro * D + col0 + bj * 128; x0 = *(const f32x4*)xp; x1 = *(const f32x4*)(xp + 4); }
                    else { const f32x2 st = rs[row0 + ro]; const u32x4 hw = *(const u32x4*)hp;
                        x0 = ((f32x4){bflo(hw.x), bfhi(hw.x), bflo(hw.y), bfhi(hw.y)} - st[0]) * st[1] * g0 + b0; x1 = ((f32x4){bflo(hw.z), bfhi(hw.z), bflo(hw.w), bfhi(hw.w)} - st[0]) * st[1] * g1 + b1; }
                    const f32x4 h0 = x0 * ALPHA + acc[ai][bj][m][0], h1 = x1 * ALPHA + acc[ai][bj][m][1];
                    *(u32x4*)hp = (u32x4){pk2(h0[0], h0[1]), pk2(h0[2], h0[3]), pk2(h1[0], h1[1]), pk2(h1[2], h1[3])};
#pragma unroll
                    for (int j = 0; j < 4; ++j) { s1[ai * 4 + m] += h0[j] + h1[j]; s2[ai * 4 + m] += h0[j] * h0[j] + h1[j] * h1[j]; }
                    asm volatile("" ::: "memory");
                }
        }
#pragma unroll
        for (int i = AI0 * 4; i < AI1 * 4; ++i) {
            float a = s1[i], q = s2[i];
            a += __shfl_xor(a, 16); a += __shfl_xor(a, 32); q += __shfl_xor(q, 16); q += __shfl_xor(q, 32);
            if (fq == 0) *(f32x2*)(stat + ((size_t)(row0 + (i >> 2) * 128 + (i & 3) * 16) * 64 + u.pn * 4 + wc) * 2) = (f32x2){a, q};
        }
    }
};
struct EpiNull {
    static constexpr bool PERM = true, AFTER_DRAIN = false;
    float* sink;
    __device__ __forceinline__ void operator()(const pg8::f32x4 (&acc)[2][2][4][2], const pg8::Unit& u, int wr, int wc, int fr, int fq) const {
        float s = 0.f;
#pragma unroll
        for (int ai = 0; ai < 2; ++ai)
#pragma unroll
            for (int bj = 0; bj < 2; ++bj)
#pragma unroll
                for (int m = 0; m < 4; ++m)
#pragma unroll
                    for (int n = 0; n < 2; ++n) s += acc[ai][bj][m][n][0] + acc[ai][bj][m][n][1] + acc[ai][bj][m][n][2] + acc[ai][bj][m][n][3];
        if (s == 12345.678f) sink[u.pm * 64 + fr] = s;
    }
};
constexpr int CW_Q = 8192, CW_CV = 16384;
struct QueueOrder {
    pg8::StaticOrder b; unsigned* q; int x; volatile LAS int* slot;
    __device__ __forceinline__ int issue(int, int wid, int lane) const {
        int L = -1;
        if (wid == 0 && lane == 0) {
            for (int y = 0; y < 8; ++y) {
                const int x2 = (x + y) & 7; const unsigned t = __hip_atomic_fetch_add(q + 64 * x2, 1u, __ATOMIC_RELAXED, __HIP_MEMORY_SCOPE_AGENT);
                const long Lc = (long)t * 8 + x2; if (Lc < b.cap) { L = (int)Lc; break; }
            }
        }
        return L;
    }
    __device__ __forceinline__ bool resolve(int L, int i, pg8::Unit& u, int wid, int lane) const {
        if (wid == 0 && lane == 0) slot[i & 1] = L;
        asm volatile("s_waitcnt lgkmcnt(0)" ::: "memory"); __builtin_amdgcn_s_barrier(); asm volatile("" ::: "memory");
        const int Lr = __builtin_amdgcn_readfirstlane(slot[i & 1]);
        return Lr >= 0 && b.unit_of(Lr, u);
    }
    __device__ __forceinline__ void a_ready(const pg8::Unit&) const {}
    __device__ __forceinline__ void done(const pg8::Unit&) const {}
};
__device__ __forceinline__ QueueOrder make_queue(const Ctx& C, unsigned char* ws_, int pid, int Mr, int Nc) {
    QueueOrder S; S.b.init(Mr, Nc, C.G, 0); S.q = (unsigned*)(ws_ + WS_CTL) + CW_Q + pid * 8 * 64; S.x = C.bid & 7; S.slot = (volatile LAS int*)(C.lds + MISC_OFF) + 16; return S;
}
struct SplitOrder {
    pg8::StaticOrder b; long L;
    __device__ bool next(int i, pg8::Unit& u) const { return i == 0 && b.unit_of(L, u); }
    __device__ __forceinline__ int issue(int, int, int) const { return 0; }
    __device__ __forceinline__ bool resolve(int, int i, pg8::Unit& u, int, int) const { return next(i, u); }
    __device__ __forceinline__ void a_ready(const pg8::Unit&) const {}
    __device__ __forceinline__ void done(const pg8::Unit&) const {}
};
struct EpiPartial {
    static constexpr bool PERM = true, AFTER_DRAIN = false;
    float* slab;
    __device__ __forceinline__ void operator()(const pg8::f32x4 (&acc)[2][2][4][2], const pg8::Unit&, int wr, int wc, int fr, int fq) const {
        const unsigned t = (unsigned)(((wr * 4 + wc) * 4 + fq) * 16 + fr);
#pragma unroll
        for (int ai = 0; ai < 2; ++ai)
#pragma unroll
            for (int bj = 0; bj < 2; ++bj)
#pragma unroll
                for (int m = 0; m < 4; ++m)
#pragma unroll
                    for (int n = 0; n < 2; ++n) sto<pg8::f32x4>(slab, ((unsigned)((((ai * 2 + bj) * 4 + m) * 2 + n) * 512) + t) * 16u, acc[ai][bj][m][n]);
    }
};
struct EpiUpConv {
    static constexpr bool PERM = true, AFTER_DRAIN = false;
    bf16_t* HG; bf16_t* SIDE; float* cp; float* cs; const float* cw; const float* cb;
    __device__ __forceinline__ void operator()(const pg8::f32x4 (&acc)[2][2][4][2], const pg8::Unit& u, int wr, int wc, int fr, int fq) const {
        const int row0 = u.pm * 256 + wr * 64 + fr, ch0 = u.pn * 128 + wc * 32 + 8 * fq;
        const int lane = fq * 16 + fr, L1 = (lane & 48) | ((fr - 1) & 15), L2 = (lane & 48) | ((fr - 2) & 15);
        f32x4 w0[2], w1[2], w2[2], bb[2];
#pragma unroll
        for (int n = 0; n < 2; ++n) { w0[n] = *(const f32x4*)(cw + ch0 + 4 * n); w1[n] = *(const f32x4*)(cw + DFF + ch0 + 4 * n); w2[n] = *(const f32x4*)(cw + 2 * DFF + ch0 + 4 * n); bb[n] = *(const f32x4*)(cb + ch0 + 4 * n); }
#pragma unroll
        for (int ai = 0; ai < 2; ++ai) {
            f32x4 s1p[2], s2p[2];
#pragma unroll
            for (int n = 0; n < 2; ++n) { s1p[n] = (f32x4){0.f, 0.f, 0.f, 0.f}; s2p[n] = s1p[n]; }
#pragma unroll
            for (int m = 0; m < 4; ++m) {
                const int row = row0 + ai * 128 + m * 16, t = row & 31;
                u32x2 ow[2];
#pragma unroll
                for (int n = 0; n < 2; ++n) {
                    const pg8::f32x4 a = acc[ai][0][m][n], uu = acc[ai][1][m][n];
                    f32x4 s1, s2, o;
#pragma unroll
                    for (int j = 0; j < 4; ++j) { s1[j] = __shfl(a[j], L1); s2[j] = __shfl(a[j], L2); }
#pragma unroll
                    for (int j = 0; j < 4; ++j) {
                        const float p1 = fr >= 1 ? s1[j] : s1p[n][j], p2 = fr >= 2 ? s2[j] : s2p[n][j];
                        const float c = bb[n][j] + p2 * w0[n][j] + p1 * w1[n][j] + a[j] * w2[n][j];
                        o[j] = fsilu(c) * uu[j];
                    }
                    s1p[n] = s1; s2p[n] = s2;
                    ow[n].x = pk2(o[0], o[1]); ow[n].y = pk2(o[2], o[3]);
                }
                const bool inwave = (m == 2) && (u.pm < MP / 256);
                if (t >= 2 || inwave) *(u32x4*)(HG + (size_t)row * DFF + ch0) = (u32x4){ow[0].x, ow[0].y, ow[1].x, ow[1].y};
                if ((t < 2 && !inwave) || t >= 30) {
                    const pg8::f32x4 a0 = acc[ai][0][m][0], a1 = acc[ai][0][m][1];
                    bf16_t* sd = SIDE + ((size_t)(row >> 5) * 6 + (t >= 30 ? t - 30 : t + 2)) * DFF + ch0;
                    *(u32x4*)sd = (u32x4){pk2(a0[0], a0[1]), pk2(a0[2], a0[3]), pk2(a1[0], a1[1]), pk2(a1[2], a1[3])};
                    if (t < 2) { const pg8::f32x4 u0 = acc[ai][1][m][0], u1 = acc[ai][1][m][1];
                        *(u32x4*)(sd + 2 * DFF) = (u32x4){pk2(u0[0], u0[1]), pk2(u0[2], u0[3]), pk2(u1[0], u1[1]), pk2(u1[2], u1[3])}; }
                    float* dst = nullptr;
                    if (row < MP) { const int tq = row & 4095; if (tq >= 4094) dst = cp + ((size_t)(row >> 12) * 2 + (tq - 4094)) * DFF + ch0; }
                    else if (t >= 30) dst = cs + ((size_t)((row - MP) >> 5) * 2 + (t - 30)) * DFF + ch0;
                    if (dst) { *(f32x4*)dst = a0; *(f32x4*)(dst + 4) = a1; }
                }
            }
        }
    }
};
struct EpiBin {
    static constexpr bool PERM = true, AFTER_DRAIN = false;
    unsigned char* ws;
    __device__ __forceinline__ void operator()(const pg8::f32x4 (&acc)[2][2][4][2], const pg8::Unit& u, int wr, int wc, int fr, int fq) const {
        const int row0 = u.pm * 256 + wr * 64 + fr;
        if (u.pn >= 32) {
            const int col0 = (u.pn & 15) * 256 + wc * 32 + 8 * fq, sel = u.pn >> 4;
            bf16_t* dst = (bf16_t*)(ws + WS_Q + (size_t)sel * (136 * MiB));
#pragma unroll
            for (int ai = 0; ai < 2; ++ai)
#pragma unroll
                for (int m = 0; m < 4; ++m)
#pragma unroll
                    for (int bj = 0; bj < 2; ++bj) {
                        const pg8::f32x4 v0 = acc[ai][bj][m][0], v1 = acc[ai][bj][m][1];
                        u32x4 w; w.x = pk2(v0[0], v0[1]); w.y = pk2(v0[2], v0[3]); w.z = pk2(v1[0], v1[1]); w.w = pk2(v1[2], v1[3]);
                        *(u32x4*)(dst + (size_t)(row0 + ai * 128 + m * 16) * D + col0 + bj * 128) = w;
                    }
            return;
        }
        const int ch0 = u.pn * 128 + wc * 32 + 8 * fq;
        bf16_t* QS = (bf16_t*)(ws + WS_QS); bf16_t* KD = (bf16_t*)(ws + WS_KD); float* DCH = (float*)(ws + WS_DCH); const float* LB = (const float*)(ws + WS_LB);
        const f32x4 lb0 = *(const f32x4*)(LB + ch0), lb1 = *(const f32x4*)(LB + ch0 + 4);
        const int l15 = (fq * 16 + 15) * 4;
#pragma unroll
        for (int ai = 0; ai < 2; ++ai)
#pragma unroll
            for (int mp = 0; mp < 2; ++mp) {
                unsigned wq0[4], wq1[4], wk0[4], wk1[4];
#pragma unroll
                for (int n = 0; n < 2; ++n) {
                    const f32x4 lb = n ? lb1 : lb0;
                    float k0[4], k1[4], b0[4], b1[4];
#pragma unroll
                    for (int j = 0; j < 4; ++j) {
                        const float om = 1.0f - lb[j];
                        const float e0 = fexp(-acc[ai][1][2 * mp][n][j]), e1 = fexp(-acc[ai][1][2 * mp + 1][n][j]);
                        const float r0 = frcp(1.0f + e0), r1 = frcp(1.0f + e1);
                        k0[j] = om * e0 * r0; k1[j] = om * e1 * r1;
                        b0[j] = __builtin_amdgcn_logf(lb[j] + om * r0); b1[j] = __builtin_amdgcn_logf(lb[j] + om * r1);
                    }
#pragma unroll
                    for (int j = 0; j < 4; ++j) {
                        b0[j] += __int_as_float(__builtin_amdgcn_update_dpp(0, __float_as_int(b0[j]), 0x111, 0xf, 0xf, true));
                        b1[j] += __int_as_float(__builtin_amdgcn_update_dpp(0, __float_as_int(b1[j]), 0x111, 0xf, 0xf, true));
                    }
#pragma unroll
                    for (int j = 0; j < 4; ++j) {
                        b0[j] += __int_as_float(__builtin_amdgcn_update_dpp(0, __float_as_int(b0[j]), 0x112, 0xf, 0xf, true));
                        b1[j] += __int_as_float(__builtin_amdgcn_update_dpp(0, __float_as_int(b1[j]), 0x112, 0xf, 0xf, true));
                    }
#pragma unroll
                    for (int j = 0; j < 4; ++j) {
                        b0[j] += __int_as_float(__builtin_amdgcn_update_dpp(0, __float_as_int(b0[j]), 0x114, 0xf, 0xf, true));
                        b1[j] += __int_as_float(__builtin_amdgcn_update_dpp(0, __float_as_int(b1[j]), 0x114, 0xf, 0xf, true));
                    }
#pragma unroll
                    for (int j = 0; j < 4; ++j) {
                        b0[j] += __int_as_float(__builtin_amdgcn_update_dpp(0, __float_as_int(b0[j]), 0x118, 0xf, 0xf, true));
                        b1[j] += __int_as_float(__builtin_amdgcn_update_dpp(0, __float_as_int(b1[j]), 0x118, 0xf, 0xf, true));
                    }
                    float qs0[4], qs1[4], kd0[4], kd1[4]; f32x4 et;
#pragma unroll
                    for (int j = 0; j < 4; ++j) {
                        b1[j] += __int_as_float(__builtin_amdgcn_ds_bpermute(l15, __float_as_int(b0[j])));
                        const float eb0 = __builtin_amdgcn_exp2f(b0[j]), eb1 = __builtin_amdgcn_exp2f(b1[j]);
                        qs0[j] = acc[ai][0][2 * mp][n][j] * eb0; qs1[j] = acc[ai][0][2 * mp + 1][n][j] * eb1;
                        kd0[j] = k0[j] * frcp(eb0); kd1[j] = k1[j] * frcp(eb1);
                        et[j] = eb1;
                    }
                    wq0[2 * n] = pk2(qs0[0], qs0[1]); wq0[2 * n + 1] = pk2(qs0[2], qs0[3]); wq1[2 * n] = pk2(qs1[0], qs1[1]); wq1[2 * n + 1] = pk2(qs1[2], qs1[3]);
                    wk0[2 * n] = pk2(kd0[0], kd0[1]); wk0[2 * n + 1] = pk2(kd0[2], kd0[3]); wk1[2 * n] = pk2(kd1[0], kd1[1]); wk1[2 * n + 1] = pk2(kd1[2], kd1[3]);
                    if (fr == 15) *(f32x4*)(DCH + (size_t)(u.pm * 8 + ai * 4 + wr * 2 + mp) * D + ch0 + 4 * n) = et;
                }
                const size_t o0 = (size_t)(row0 + ai * 128 + mp * 32) * D + ch0, o1 = o0 + (size_t)16 * D;
                u32x4 w;
                w.x = wq0[0]; w.y = wq0[1]; w.z = wq0[2]; w.w = wq0[3]; *(u32x4*)(QS + o0) = w;
                w.x = wq1[0]; w.y = wq1[1]; w.z = wq1[2]; w.w = wq1[3]; *(u32x4*)(QS + o1) = w;
                w.x = wk0[0]; w.y = wk0[1]; w.z = wk0[2]; w.w = wk0[3]; *(u32x4*)(KD + o0) = w;
                w.x = wk1[0]; w.y = wk1[1]; w.z = wk1[2]; w.w = wk1[3]; *(u32x4*)(KD + o1) = w;
            }
    }
};

struct CvItem { const float* src; bf16_t* dst; int K, N; };
__device__ __forceinline__ void cv_load(const CvItem& d, int lane, f32x4 (&x)[16]) {
    const unsigned lo = (unsigned)((lane >> 4) * d.N + 4 * (lane & 15)) * 4u, step = (unsigned)d.N * 16u;
#pragma unroll
    for (int i = 0; i < 16; ++i) x[i] = __builtin_nontemporal_load((const f32x4*)((const char*)d.src + lo + (unsigned)i * step));
}
__device__ __forceinline__ void cv_store(const CvItem& d, int lane, const f32x4 (&x)[16], LAS float* scr) {
#pragma unroll
    for (int i = 0; i < 16; ++i) {
        LAS float* p = scr + (4 * i + (lane >> 4)) * 65 + 4 * (lane & 15);
        p[0] = x[i][0]; p[1] = x[i][1]; p[2] = x[i][2]; p[3] = x[i][3];
    }
    LDS_WAIT();
    const int c = lane & 7;
#pragma unroll
    for (int j = 0; j < 8; ++j) {
        const int n = (lane >> 3) + 8 * j; const LAS float* s = scr + (8 * c) * 65 + n;
        u32x4 o; o.x = pk2(s[0], s[65]); o.y = pk2(s[2 * 65], s[3 * 65]); o.z = pk2(s[4 * 65], s[5 * 65]); o.w = pk2(s[6 * 65], s[7 * 65]);
        __builtin_nontemporal_store(o, (u32x4*)((char*)d.dst + (unsigned)(n * d.K + 8 * c) * 2u));
    }
    LDS_WAIT();
}
constexpr int I_AIN = 64 * 128, I_AOUT = 64 * 64, I_BIN = 64 * 256, I_BOUT = 64 * 64, I_UP = 64 * 344, I_DN = 172 * 64;
constexpr int CV_DN0A = 7400, CV_UP0A = 6000;
constexpr int CV_S0 = 0;
constexpr int CV_S1 = CV_S0 + I_AIN + CV_DN0A;
constexpr int CV_S2 = CV_S1 + I_AOUT + CV_UP0A;
constexpr int CV_S3 = CV_S2 + (I_UP - CV_UP0A);
constexpr int CV_S4 = CV_S3 + (I_DN - CV_DN0A);
constexpr int CV_S4B = CV_S4 + I_BIN + I_BOUT + I_UP / 2;
constexpr int CV_S5 = CV_S4B + I_UP - I_UP / 2;
constexpr int CV_END = CV_S5 + I_DN;
__device__ __forceinline__ CvItem cv_decode(const Ctx& C, unsigned char* ws_, int it) {
    int r = it; const float* W; bf16_t* WT; int K, N, kind = 0;
    if (r < I_AIN) { W = inp(C, 4); WT = (bf16_t*)(ws_ + WS_W_AIN); K = D; N = NAIN; }
    else if ((r -= I_AIN) < CV_DN0A) { W = inp(C, 17); WT = (bf16_t*)(ws_ + WS_W_DN0); K = DFF; N = D; }
    else if ((r -= CV_DN0A) < I_AOUT) { W = inp(C, 9); WT = (bf16_t*)(ws_ + WS_W_AOUT); K = D; N = D; }
    else if ((r -= I_AOUT) < I_UP) { W = inp(C, 14); WT = (bf16_t*)(ws_ + WS_W_UP0); K = D; N = NUP; kind = 1; }
    else if ((r -= I_UP) < I_DN - CV_DN0A) { r += CV_DN0A; W = inp(C, 17); WT = (bf16_t*)(ws_ + WS_W_DN0); K = DFF; N = D; }
    else if ((r -= I_DN - CV_DN0A) < I_BIN) { W = inp(C, 10); WT = (bf16_t*)(ws_ + WS_W_BIN); K = D; N = NBIN; kind = 2; }
    else if ((r -= I_BIN) < I_BOUT) { W = inp(C, 13); WT = (bf16_t*)(ws_ + WS_W_BOUT); K = D; N = D; }
    else if ((r -= I_BOUT) < I_UP) { W = inp(C, 14) + (size_t)D * NUP; WT = (bf16_t*)(ws_ + WS_W_UP1); K = D; N = NUP; kind = 1; }
    else { r -= I_UP; W = inp(C, 17) + (size_t)DFF * D; WT = (bf16_t*)(ws_ + WS_W_DN1); K = DFF; N = D; }
    const int nblk = N / 64, kb = r / nblk, nb = r % nblk, n0 = nb * 64;
    int drow0 = n0;
    if (kind == 1) { const int h = n0 >= DFF ? 1 : 0, c = n0 - h * DFF; drow0 = 256 * (c >> 7) + 128 * h + (c & 127); }
    if (kind == 2 && n0 < 2 * D) { const int h = n0 >= D ? 1 : 0, c = n0 - h * D; drow0 = 256 * (c >> 7) + 128 * h + (c & 127); }
    CvItem d; d.src = W + (size_t)(kb * 64) * N + n0; d.dst = WT + (size_t)drow0 * K + kb * 64; d.K = K; d.N = N; return d;
}
__device__ __forceinline__ void conv_range(const Ctx& C, int lo, int hi, int rank, int nranks) {
    unsigned char* const ws_ = wsp(C);
    LAS float* scr = (LAS float*)(C.lds + C.wave * 16640);
    int it = lo + rank;
    if (it >= hi) return;
    CvItem d = cv_decode(C, ws_, it); f32x4 cur[16], nxt[16];
    cv_load(d, C.lane, cur);
    for (;;) {
        const int itn = it + nranks; const bool more = itn < hi;
        CvItem dn = d;
        if (more) { dn = cv_decode(C, ws_, itn); cv_load(dn, C.lane, nxt); }
        cv_store(d, C.lane, cur, scr);
        if (!more) break;
#pragma unroll
        for (int i = 0; i < 16; ++i) cur[i] = nxt[i];
        d = dn; it = itn;
    }
}
__device__ __forceinline__ void conv_queue(const Ctx& C, int seg, int lo, int hi) {
    unsigned char* const ws_ = wsp(C);
    unsigned* ctr = (unsigned*)(ws_ + WS_CTL) + CW_CV + seg * 64;
    LAS float* scr = (LAS float*)(C.lds + C.wave * 16640);
    for (;;) {
        unsigned t = 0; if (C.lane == 0) t = __hip_atomic_fetch_add(ctr, 1u, __ATOMIC_RELAXED, __HIP_MEMORY_SCOPE_AGENT);
        t = (unsigned)__builtin_amdgcn_readfirstlane((int)t);
        const int it0 = lo + (int)t * 4; if (it0 >= hi) break;
        for (int it = it0; it < it0 + 4 && it < hi; ++it) { const CvItem d = cv_decode(C, ws_, it); f32x4 x[16]; cv_load(d, C.lane, x); cv_store(d, C.lane, x, scr); }
    }
    __syncthreads();
}
__device__ __forceinline__ void conv_tail(const Ctx& C, int nwg, int lo, int hi) {
    const int R = (nwg + C.G - 1) / C.G - 1, nbusy = nwg - R * C.G;
    if (nbusy >= C.G) conv_range(C, lo, hi, C.bid * 8 + C.wave, C.G * 8);
    else if (C.bid >= nbusy) conv_range(C, lo, hi, (C.bid - nbusy) * 8 + C.wave, (C.G - nbusy) * 8);
    __syncthreads();
}
__device__ __forceinline__ void p0_prologue(const Ctx& C0) {
    const Ctx C = C0;
    unsigned char* const ws_ = wsp(C);
    conv_range(C, CV_S0, CV_S1, C.bid * 8 + C.wave, C.G * 8);
    bf16_t* XB = (bf16_t*)(ws_ + WS_XB); const float* const xp_ = inp(C, 0); const float* const xs_ = inp(C, 1);
    for (size_t i = (size_t)C.bid * 512 + C.tid; i < (size_t)M * D / 8; i += (size_t)C.G * 512) {
        const int row = (int)(i >> 9), c8 = (int)(i & 511);
        const float* xr = xin_row(xp_, xs_, row) + c8 * 8;
        const f32x4 a = *(const f32x4*)xr, b = *(const f32x4*)(xr + 4);
        u32x4 w; w.x = pk2(a[0], a[1]); w.y = pk2(a[2], a[3]); w.z = pk2(b[0], b[1]); w.w = pk2(b[2], b[3]);
        *(u32x4*)(XB + (size_t)row * D + c8 * 8) = w;
    }
    float* LB = (float*)(ws_ + WS_LB);
    const float* const blb_ = inp(C, 11);
    for (int i = C.bid * 512 + C.tid; i < D; i += C.G * 512) { const float b0 = blb_[i], b1 = blb_[D + i]; LB[i] = 1.0f / (1.0f + expf(b0 - b1)); }
}

__device__ __forceinline__ void p_rowstat(const Ctx& C0) {
    const Ctx C = C0;
    unsigned char* const ws_ = wsp(C);
    const f32x2* stat = (const f32x2*)(ws_ + WS_STAT); f32x2* rs = (f32x2*)(ws_ + WS_ROWSTAT);
    for (int row = C.bid * 8 + C.wave; row < M; row += C.G * 8) {
        const f32x2 sl = stat[(size_t)row * 64 + C.lane];
        const float s1 = wave_sum(sl[0]), s2 = wave_sum(sl[1]);
        const float mean = s1 * (1.0f / D), var = s2 * (1.0f / D) - mean * mean;
        if (C.lane == 0) rs[row] = (f32x2){mean, 1.0f / sqrtf(var + LN_EPS)};
    }
}
__device__ __forceinline__ void p_ln_apply(const Ctx& C0, const float* g, const float* b, bf16_t* XBo, float* Yo) {
    const Ctx C = C0;
    unsigned char* const ws_ = wsp(C);
    const bf16_t* H = (const bf16_t*)(ws_ + WS_H32); const f32x2* stat = (const f32x2*)(ws_ + WS_STAT); f32x2* rs2 = (f32x2*)(ws_ + WS_RS2);
    const unsigned loff = (unsigned)C.lane * 16u;
    const int step = C.G * 8;
    int row = C.bid * 8 + C.wave;
    if (row >= M) return;
    f32x2 sl = stat[(size_t)row * 64 + C.lane];
    u32x4 hw[8];
#pragma unroll
    for (int j = 0; j < 8; ++j) hw[j] = ldo<u32x4>(H + (size_t)row * D, loff + (unsigned)j * 1024u);
    for (; row < M; row += step) {
        const int nrow = row + step < M ? row + step : row;
        const f32x2 sln = stat[(size_t)nrow * 64 + C.lane];
        u32x4 hn[8];
#pragma unroll
        for (int j = 0; j < 8; ++j) hn[j] = ldo<u32x4>(H + (size_t)nrow * D, loff + (unsigned)j * 1024u);
        const float s1 = wave_sum(sl[0]), s2 = wave_sum(sl[1]);
        const float mean = s1 * (1.0f / D), var = s2 * (1.0f / D) - mean * mean, rstd = 1.0f / sqrtf(var + LN_EPS);
        if (C.lane == 0) rs2[row] = (f32x2){mean, rstd};
#pragma unroll
        for (int j = 0; j < 8; ++j) {
            const int c = 512 * j + 8 * C.lane;
            const f32x4 v0 = {bflo(hw[j].x), bfhi(hw[j].x), bflo(hw[j].y), bfhi(hw[j].y)}, v1 = {bflo(hw[j].z), bfhi(hw[j].z), bflo(hw[j].w), bfhi(hw[j].w)};
            const f32x4 g0 = *(const f32x4*)(g + c), g1 = *(const f32x4*)(g + c + 4), b0 = *(const f32x4*)(b + c), b1 = *(const f32x4*)(b + c + 4);
            const f32x4 y0 = (v0 - mean) * rstd * g0 + b0, y1 = (v1 - mean) * rstd * g1 + b1;
            if (Yo) { __builtin_nontemporal_store(y0, (f32x4*)(Yo + (size_t)row * D + c)); __builtin_nontemporal_store(y1, (f32x4*)(Yo + (size_t)row * D + c + 4)); }
            if (XBo) { u32x4 w; w.x = pk2(y0[0], y0[1]); w.y = pk2(y0[2], y0[3]); w.z = pk2(y1[0], y1[1]); w.w = pk2(y1[2], y1[3]); *(u32x4*)(XBo + (size_t)row * D + c) = w; }
        }
        sl = sln;
#pragma unroll
        for (int j = 0; j < 8; ++j) hw[j] = hn[j];
    }
}
__device__ __forceinline__ void p_convfix(const Ctx& C0, int layer) {
    const Ctx C = C0;
    unsigned char* const ws_ = wsp(C);
    const bf16_t* SIDE = (const bf16_t*)(ws_ + WS_SIDE); bf16_t* HG = (bf16_t*)(ws_ + WS_HG);
    const float* cw = inp(C, 15) + (size_t)layer * 3 * DFF; const float* cb = inp(C, 16) + (size_t)layer * DFF;
    const float* cache = inp(C, 3) + (size_t)layer * 32 * 2 * DFF;
    constexpr int NCH = DFF / 8, NCK = MP / 64 + (M - MP) / 32;
    for (int task = C.bid * 512 + C.tid; task < NCK * NCH; task += C.G * 512) {
        const int ki = task / NCH, q = task - ki * NCH, c = 8 * q, k = ki < MP / 64 ? 2 * ki : MP / 32 + (ki - MP / 64);
        float w0[8], w1[8], w2[8], bb[8], p1[8], p2[8], a0[8], a1[8], u0[8], u1[8];
#pragma unroll
        for (int j = 0; j < 8; ++j) { w0[j] = cw[c + j]; w1[j] = cw[DFF + c + j]; w2[j] = cw[2 * DFF + c + j]; bb[j] = cb[c + j]; p1[j] = 0.f; p2[j] = 0.f; }
        if (k >= MP / 32) {
            const float* cs = cache + (size_t)(k - MP / 32) * 2 * DFF + c;
#pragma unroll
            for (int j = 0; j < 8; ++j) { p2[j] = cs[j]; p1[j] = cs[DFF + j]; }
        } else if ((k & 127) != 0) {
            const u32x4 x2 = *(const u32x4*)(SIDE + ((size_t)(k - 1) * 6 + 0) * DFF + c), x1 = *(const u32x4*)(SIDE + ((size_t)(k - 1) * 6 + 1) * DFF + c);
#pragma unroll
            for (int j = 0; j < 4; ++j) { p2[2 * j] = bflo(x2[j]); p2[2 * j + 1] = bfhi(x2[j]); p1[2 * j] = bflo(x1[j]); p1[2 * j + 1] = bfhi(x1[j]); }
        }
        const bf16_t* sd = SIDE + (size_t)k * 6 * DFF + c;
        const u32x4 xa0 = *(const u32x4*)(sd + 2 * DFF), xa1 = *(const u32x4*)(sd + 3 * DFF), xu0 = *(const u32x4*)(sd + 4 * DFF), xu1 = *(const u32x4*)(sd + 5 * DFF);
#pragma unroll
        for (int j = 0; j < 4; ++j) { a0[2 * j] = bflo(xa0[j]); a0[2 * j + 1] = bfhi(xa0[j]); a1[2 * j] = bflo(xa1[j]); a1[2 * j + 1] = bfhi(xa1[j]);
                                       u0[2 * j] = bflo(xu0[j]); u0[2 * j + 1] = bfhi(xu0[j]); u1[2 * j] = bflo(xu1[j]); u1[2 * j + 1] = bfhi(xu1[j]); }
        float o0[8], o1[8];
#pragma unroll
        for (int j = 0; j < 8; ++j) {
            const float c0 = bb[j] + p2[j] * w0[j] + p1[j] * w1[j] + a0[j] * w2[j];
            const float c1 = bb[j] + p1[j] * w0[j] + a0[j] * w1[j] + a1[j] * w2[j];
            o0[j] = fsilu(c0) * u0[j]; o1[j] = fsilu(c1) * u1[j];
        }
        *(u32x4*)(HG + (size_t)(32 * k) * DFF + c) = (u32x4){pk2(o0[0], o0[1]), pk2(o0[2], o0[3]), pk2(o0[4], o0[5]), pk2(o0[6], o0[7])};
        *(u32x4*)(HG + (size_t)(32 * k + 1) * DFF + c) = (u32x4){pk2(o1[0], o1[1]), pk2(o1[2], o1[3]), pk2(o1[4], o1[5]), pk2(o1[6], o1[7])};
    }
}

constexpr int SG_WS = 0, SG_VN = 34816, SG_MX = 69632, SG_ROW = 272, SG_MXROW = 528;
__device__ __forceinline__ void p_spatial(const Ctx& C0) {
    const Ctx C = C0;
    unsigned char* const ws_ = wsp(C); float* const out_ = outp(C);
    const bf16_t* Z = (const bf16_t*)(ws_ + WS_Z); bf16_t* GATED = (bf16_t*)(ws_ + WS_GATED);
    const f32x2* rs = (const f32x2*)(ws_ + WS_ROWSTAT);
    const float* w_s = inp(C, 7); const float* b_s = inp(C, 8); const float* ln_g = inp(C, 5); const float* ln_b = inp(C, 6);
    LAS unsigned char* lds = C.lds;
    const int tid = C.tid, lane = C.lane, wave = C.wave, wr = wave >> 2, wc = wave & 3, c16 = lane & 15, hh = lane >> 4, q4 = (lane & 15) >> 2, p4 = lane & 3;
    int cur_g = -1, cur_type = -1;
    float lg[8], lbv[8], bsv[4];
    for (int u = C.bid; u < (M / 128) * 32; u += C.G) {
        const int rb = u >> 5, g = u & 31, r0 = rb * 128, type = (r0 >= MP) ? 1 : 0;
        u32x4 U16[4], V16[4]; f32x2 st[4];
        const int c8 = tid & 15;
#pragma unroll
        for (int k = 0; k < 4; ++k) {
            const int t = (tid >> 4) + 32 * k;
            const bf16_t* zr = Z + (size_t)(r0 + t) * NAIN + g * 128 + c8 * 8;
            U16[k] = *(const u32x4*)zr; V16[k] = *(const u32x4*)(zr + D); st[k] = rs[r0 + t];
        }
        if (g != cur_g || type != cur_type) {
            __syncthreads();
            const int t = tid >> 2, sq = tid & 3;
#pragma unroll
            for (int s8 = 0; s8 < 4; ++s8) {
                const int s0 = 32 * sq + 8 * s8; float wv[8];
                if (type == 0) {
                    const float* src = w_s + ((size_t)g * 128 + t) * 128 + s0;
                    const f32x4 a = *(const f32x4*)src, b = *(const f32x4*)(src + 4);
#pragma unroll
                    for (int j = 0; j < 4; ++j) { wv[j] = (s0 + j <= t) ? a[j] : 0.f; wv[4 + j] = (s0 + 4 + j <= t) ? b[j] : 0.f; }
                } else {
                    const int tl = t & 31, sl = s0 & 31; const bool same = (t >> 5) == (s0 >> 5);
                    const float* src = w_s + ((size_t)g * 128 + tl) * 128 + sl;
                    const f32x4 a = *(const f32x4*)src, b = *(const f32x4*)(src + 4);
#pragma unroll
                    for (int j = 0; j < 4; ++j) { wv[j] = (same && sl + j <= tl) ? a[j] : 0.f; wv[4 + j] = (same && sl + 4 + j <= tl) ? b[j] : 0.f; }
                }
                u32x4 w; w.x = pk2(wv[0], wv[1]); w.y = pk2(wv[2], wv[3]); w.z = pk2(wv[4], wv[5]); w.w = pk2(wv[6], wv[7]);
                *(LAS u32x4*)(lds + SG_WS + t * SG_ROW + s0 * 2) = w;
            }
#pragma unroll
            for (int j = 0; j < 8; ++j) { lg[j] = ln_g[g * 128 + c8 * 8 + j]; lbv[j] = ln_b[g * 128 + c8 * 8 + j]; }
#pragma unroll
            for (int tt = 0; tt < 4; ++tt) { const int t2 = 64 * wr + 16 * tt + c16; bsv[tt] = b_s[g * 128 + (type ? (t2 & 31) : t2)]; }
            cur_g = g; cur_type = type;
        }
#pragma unroll
        for (int k = 0; k < 4; ++k) {
            const int t = (tid >> 4) + 32 * k; float vn[8];
#pragma unroll
            for (int j = 0; j < 4; ++j) {
                vn[2 * j] = (bflo(V16[k][j]) - st[k][0]) * st[k][1] * lg[2 * j] + lbv[2 * j];
                vn[2 * j + 1] = (bfhi(V16[k][j]) - st[k][0]) * st[k][1] * lg[2 * j + 1] + lbv[2 * j + 1];
            }
            if (type) { float* nv = out_ + OUT_NV + (size_t)(r0 + t - MP) * D + g * 128 + c8 * 8;
                *(f32x4*)nv = (f32x4){vn[0], vn[1], vn[2], vn[3]}; *(f32x4*)(nv + 4) = (f32x4){vn[4], vn[5], vn[6], vn[7]}; }
            u32x4 w; w.x = pk2(vn[0], vn[1]); w.y = pk2(vn[2], vn[3]); w.z = pk2(vn[4], vn[5]); w.w = pk2(vn[6], vn[7]);
            *(LAS u32x4*)(lds + SG_VN + t * SG_ROW + c8 * 16) = w;
        }
        __syncthreads();
        f32x4 acc[2][4];
#pragma unroll
        for (int ct = 0; ct < 2; ++ct)
#pragma unroll
            for (int tt = 0; tt < 4; ++tt) acc[ct][tt] = (f32x4){0.f, 0.f, 0.f, 0.f};
#pragma unroll
        for (int kk = 0; kk < 4; ++kk) {
            bf16x8 a[2], b[4];
#pragma unroll
            for (int ct = 0; ct < 2; ++ct) {
                LAS unsigned char* p = lds + SG_VN + (32 * kk + 8 * hh + q4) * SG_ROW + (32 * wc + 16 * ct + 4 * p4) * 2;
                a[ct] = cat4(lds_tr(p), lds_tr(p + 4 * SG_ROW));
            }
#pragma unroll
            for (int tt = 0; tt < 4; ++tt) b[tt] = *(const LAS bf16x8*)(lds + SG_WS + (64 * wr + 16 * tt + c16) * SG_ROW + (32 * kk + 8 * hh) * 2);
#pragma unroll
            for (int ct = 0; ct < 2; ++ct)
#pragma unroll
                for (int tt = 0; tt < 4; ++tt) acc[ct][tt] = __builtin_amdgcn_mfma_f32_16x16x32_bf16(a[ct], b[tt], acc[ct][tt], 0, 0, 0);
        }
#pragma unroll
        for (int ct = 0; ct < 2; ++ct)
#pragma unroll
            for (int tt = 0; tt < 4; ++tt)
                *(LAS f32x4*)(lds + SG_MX + (64 * wr + 16 * tt + c16) * SG_MXROW + (32 * wc + 16 * ct + 4 * hh) * 4) = acc[ct][tt] + bsv[tt];
        __syncthreads();
#pragma unroll
        for (int k = 0; k < 4; ++k) {
            const int t = (tid >> 4) + 32 * k;
            const f32x4 m0 = *(const LAS f32x4*)(lds + SG_MX + t * SG_MXROW + c8 * 32), m1 = *(const LAS f32x4*)(lds + SG_MX + t * SG_MXROW + c8 * 32 + 16);
            u32x4 w;
            w.x = pk2(bflo(U16[k][0]) * m0[0], bfhi(U16[k][0]) * m0[1]); w.y = pk2(bflo(U16[k][1]) * m0[2], bfhi(U16[k][1]) * m0[3]);
            w.z = pk2(bflo(U16[k][2]) * m1[0], bfhi(U16[k][2]) * m1[1]); w.w = pk2(bflo(U16[k][3]) * m1[2], bfhi(U16[k][3]) * m1[3]);
            *(u32x4*)(GATED + (size_t)(r0 + t) * D + g * 128 + c8 * 8) = w;
        }
    }
    __syncthreads();
}


#ifndef GLA_PROMPT_REPS
#define GLA_PROMPT_REPS 1
#endif
constexpr int GL_QS = 0, GL_KD = 8704, GL_V = 17408, GL_G = 26112, GL_DCH = 34816, GL_BUF = 35328, GL_OT = 2 * GL_BUF, GL_OTSZ = 32 * 528, GL_ROW = 272, GL_OTROW = 528;
#define GLA_NORM(PK, GATE) do { const int pk_ = (PK); \
            LAS unsigned char* OTp = lds + GL_OT + (pk_ & 1) * GL_OTSZ; const int orow = 4 * w + hh; \
            const f32x4 x0 = *(const LAS f32x4*)(OTp + orow * GL_OTROW + c16 * 32), x1 = *(const LAS f32x4*)(OTp + orow * GL_OTROW + c16 * 32 + 16); \
            float ss = x0[0] * x0[0] + x0[1] * x0[1] + x0[2] * x0[2] + x0[3] * x0[3] + x1[0] * x1[0] + x1[1] * x1[1] + x1[2] * x1[2] + x1[3] * x1[3]; \
            ss += __shfl_xor(ss, 1); ss += __shfl_xor(ss, 2); ss += __shfl_xor(ss, 4); ss += __shfl_xor(ss, 8); \
            const float rn = 1.0f / sqrtf(ss * (1.0f / 128.0f) + RMS_EPS); \
            u32x4 wv; \
            wv.x = pk2(x0[0] * rn * g0[0] * fsilu(bflo(GATE[0])), x0[1] * rn * g0[1] * fsilu(bfhi(GATE[0]))); \
            wv.y = pk2(x0[2] * rn * g0[2] * fsilu(bflo(GATE[1])), x0[3] * rn * g0[3] * fsilu(bfhi(GATE[1]))); \
            wv.z = pk2(x1[0] * rn * g1[0] * fsilu(bflo(GATE[2])), x1[1] * rn * g1[1] * fsilu(bfhi(GATE[2]))); \
            wv.w = pk2(x1[2] * rn * g1[2] * fsilu(bflo(GATE[3])), x1[3] * rn * g1[3] * fsilu(bfhi(GATE[3]))); \
            sto<u32x4>(O + (size_t)(rbase + 32 * pk_) * D + cb, ooff, wv); } while (0)
#define GLA_STEP(CKV, WRSET, LDSET) do { const int ck = (CKV); \
            LAS unsigned char* B = lds + (ck & 1) * GL_BUF; \
            LAS unsigned char* OT = lds + GL_OT + (ck & 1) * GL_OTSZ; \
            const int r0 = rbase + 32 * ck; \
            const bool more = ck + 1 < nck; \
            const size_t uo = (size_t)r0 * D + cb; \
            { const int c2 = ck + 2 < nck ? ck + 2 : nck - 1;     \
              const size_t u2 = (size_t)(rbase + 32 * c2) * D + cb; LDSET##a = ldo<u32x4>(QS + u2, soff); LDSET##b = ldo<u32x4>(KD + u2, soff); LDSET##d = ldo<u32x4>(V + u2, soff); LDSET##e = ldo<u32x4>(Gt + u2, soff); \
              if (w == 0) LDSET##f = ldo<f32x4>(DCH + (size_t)((rbase >> 5) + c2) * D + cb, (unsigned)(tid & 31) * 16u); }     \
            f32x4 dch[8]; \
_Pragma("unroll") \
            for (int i = 0; i < 8; ++i) dch[i] = *(const LAS f32x4*)(B + GL_DCH + (16 * i + 4 * hh) * 4); \
            f32x4 a00 = {0.f, 0.f, 0.f, 0.f}, a01 = a00, a11 = a00; \
_Pragma("unroll") \
            for (int kk = 0; kk < 4; ++kk) { \
                const int co = (32 * kk + 8 * hh) * 2; \
                const bf16x8 k0 = *(const LAS bf16x8*)(B + GL_KD + c16 * GL_ROW + co), k1 = *(const LAS bf16x8*)(B + GL_KD + (16 + c16) * GL_ROW + co); \
                const bf16x8 q0 = *(const LAS bf16x8*)(B + GL_QS + c16 * GL_ROW + co), q1 = *(const LAS bf16x8*)(B + GL_QS + (16 + c16) * GL_ROW + co); \
                a00 = __builtin_amdgcn_mfma_f32_16x16x32_bf16(k0, q0, a00, 0, 0, 0); \
                a01 = __builtin_amdgcn_mfma_f32_16x16x32_bf16(k0, q1, a01, 0, 0, 0); \
                a11 = __builtin_amdgcn_mfma_f32_16x16x32_bf16(k1, q1, a11, 0, 0, 0); \
            } \
            if (ck > 0) GLA_NORM(ck - 1, gprev); \
            gprev = *(const LAS u32x4*)(B + GL_G + (4 * w + hh) * GL_ROW + c16 * 16); \
_Pragma("unroll") \
            for (int r = 0; r < 4; ++r) { if (4 * hh + r > c16) { a00[r] = 0.f; a11[r] = 0.f; } } \
            bf16x8 P0, P1; \
            { u32x4 t; t.x = pk2(a00[0], a00[1]); t.y = pk2(a00[2], a00[3]); t.z = 0u; t.w = 0u; P0 = __builtin_bit_cast(bf16x8, t); } \
            { u32x4 t; t.x = pk2(a01[0], a01[1]); t.y = pk2(a01[2], a01[3]); t.z = pk2(a11[0], a11[1]); t.w = pk2(a11[2], a11[3]); P1 = __builtin_bit_cast(bf16x8, t); } \
            LAS unsigned char* vp = B + GL_V + (4 * hh + q4) * GL_ROW + (16 * w + 4 * p4) * 2; \
            const bf16x8 vB = cat4(lds_tr(vp), lds_tr(vp + 16 * GL_ROW)); \
            f32x4 o0 = {0.f, 0.f, 0.f, 0.f}, o1 = o0; \
            o0 = __builtin_amdgcn_mfma_f32_16x16x32_bf16(P0, vB, o0, 0, 0, 0); \
            o1 = __builtin_amdgcn_mfma_f32_16x16x32_bf16(P1, vB, o1, 0, 0, 0); \
_Pragma("unroll") \
            for (int kk = 0; kk < 4; ++kk) { \
                u32x4 sb; sb.x = pk2(S[2 * kk][0], S[2 * kk][1]); sb.y = pk2(S[2 * kk][2], S[2 * kk][3]); sb.z = pk2(S[2 * kk + 1][0], S[2 * kk + 1][1]); sb.w = pk2(S[2 * kk + 1][2], S[2 * kk + 1][3]); \
                const bf16x8 bS = __builtin_bit_cast(bf16x8, sb); \
                const int co = (32 * kk + 4 * hh) * 2; \
                const s16x4 x0 = *(const LAS s16x4*)(B + GL_QS + c16 * GL_ROW + co), x1 = *(const LAS s16x4*)(B + GL_QS + c16 * GL_ROW + co + 32); \
                const s16x4 y0 = *(const LAS s16x4*)(B + GL_QS + (16 + c16) * GL_ROW + co), y1 = *(const LAS s16x4*)(B + GL_QS + (16 + c16) * GL_ROW + co + 32); \
                o0 = __builtin_amdgcn_mfma_f32_16x16x32_bf16(cat4(x0, x1), bS, o0, 0, 0, 0); \
                o1 = __builtin_amdgcn_mfma_f32_16x16x32_bf16(cat4(y0, y1), bS, o1, 0, 0, 0); \
            } \
            { \
                LAS unsigned char* vq = B + GL_V + (8 * hh + q4) * GL_ROW + (16 * w + 4 * p4) * 2; \
                const bf16x8 vN = cat4(lds_tr(vq), lds_tr(vq + 4 * GL_ROW)); \
_Pragma("unroll") \
                for (int i = 0; i < 8; ++i) { \
                    LAS unsigned char* kp = B + GL_KD + (8 * hh + q4) * GL_ROW + (16 * i + 4 * p4) * 2; \
                    const bf16x8 kA = cat4(lds_tr(kp), lds_tr(kp + 4 * GL_ROW)); \
                    S[i] = __builtin_amdgcn_mfma_f32_16x16x32_bf16(kA, vN, S[i], 0, 0, 0) * dch[i]; \
                } \
            } \
_Pragma("unroll") \
            for (int r = 0; r < 4; ++r) { \
                *(LAS float*)(OT + (4 * hh + r) * GL_OTROW + (16 * w + c16) * 4) = o0[r]; \
                *(LAS float*)(OT + (16 + 4 * hh + r) * GL_OTROW + (16 * w + c16) * 4) = o1[r]; \
            } \
            { \
                LAS unsigned char* dst = lds + ((ck + 1) & 1) * GL_BUF + srow * GL_ROW + sch * 16; \
                *(LAS u32x4*)(dst + GL_QS) = WRSET##a; *(LAS u32x4*)(dst + GL_KD) = WRSET##b; *(LAS u32x4*)(dst + GL_V) = WRSET##d; *(LAS u32x4*)(dst + GL_G) = WRSET##e; \
                if (tid < 32) *(LAS f32x4*)(lds + ((ck + 1) & 1) * GL_BUF + GL_DCH + tid * 16) = WRSET##f; \
            } \
            __syncthreads(); \
        } while (0)
__device__ __forceinline__ void p_gla(const Ctx& C0) {
    const Ctx C = C0;
    unsigned char* const ws_ = wsp(C); float* const out_ = outp(C);
    const bf16_t* QS = (const bf16_t*)(ws_ + WS_QS); const bf16_t* KD = (const bf16_t*)(ws_ + WS_KD);
    const bf16_t* V = (const bf16_t*)(ws_ + WS_V); const bf16_t* Gt = (const bf16_t*)(ws_ + WS_G); const float* DCH = (const float*)(ws_ + WS_DCH);
    bf16_t* O = (bf16_t*)(ws_ + WS_O); const float* gn_g = inp(C, 12); const float* S0in = inp(C, 2);
    LAS unsigned char* lds = C.lds;
    const int tid = C.tid, lane = C.lane, w = C.wave, c16 = lane & 15, hh = lane >> 4, q4 = (lane & 15) >> 2, p4 = lane & 3;
    const int srow = tid >> 4, sch = tid & 15;
    const unsigned soff = (unsigned)(srow * D + sch * 8) * 2u;
    const unsigned ooff = (unsigned)((4 * w + hh) * D + c16 * 8) * 2u;
    const unsigned stoff = (unsigned)(4 * hh * 128 + 16 * w + c16) * 4u;
    const int NPI = 128, NSI = 1024, half = C.G >= 256 ? 128 : 0;
    for (int it = 0;; ++it) {
        int item;
        if (half) { if (C.bid < half) { if (it > GLA_PROMPT_REPS - 1) break; item = C.bid; } else { item = NPI + (C.bid - half) + it * (C.G - half); if (item >= NPI + NSI) break; } }
        else { item = C.bid + it * C.G; if (item >= NPI + NSI) break; }
        int rbase, h, nck; float* Sout; const float* Sin = nullptr;
        if (item < NPI) { const int b = item >> 5; h = item & 31; rbase = b * 4096; nck = 128; Sout = out_ + OUT_SP + (size_t)item * 16384; }
        else { const int si = item - NPI, s = si >> 5; h = si & 31; rbase = MP + s * 32; nck = 1; Sout = out_ + OUT_SS + (size_t)si * 16384; Sin = S0in + (size_t)si * 16384; }
        const int cb = h * 128;
        f32x4 S[8];
#pragma unroll
        for (int i = 0; i < 8; ++i) {
            if (Sin) {
#pragma unroll
                for (int r = 0; r < 4; ++r) S[i][r] = ldo<float>(Sin + (16 * i + r) * 128, stoff);
            } else S[i] = (f32x4){0.f, 0.f, 0.f, 0.f};
        }
        __syncthreads();
        {
            const size_t u0 = (size_t)rbase * D + cb;
            const u32x4 a = ldo<u32x4>(QS + u0, soff), b = ldo<u32x4>(KD + u0, soff), d = ldo<u32x4>(V + u0, soff), e = ldo<u32x4>(Gt + u0, soff);
            LAS unsigned char* dst = lds + srow * GL_ROW + sch * 16;
            *(LAS u32x4*)(dst + GL_QS) = a; *(LAS u32x4*)(dst + GL_KD) = b; *(LAS u32x4*)(dst + GL_V) = d; *(LAS u32x4*)(dst + GL_G) = e;
            if (tid < 32) *(LAS f32x4*)(lds + GL_DCH + tid * 16) = ldo<f32x4>(DCH + (size_t)(rbase >> 5) * D + cb, (unsigned)tid * 16u);
        }
        __syncthreads();
        const f32x4 g0 = ldo<f32x4>(gn_g + cb, (unsigned)c16 * 32u), g1 = ldo<f32x4>(gn_g + cb, (unsigned)c16 * 32u + 16u);
        u32x4 RAa, RAb, RAd, RAe, RBa, RBb, RBd, RBe; f32x4 RAf = {0.f, 0.f, 0.f, 0.f}, RBf = RAf;
        { const int c1 = nck > 1 ? 1 : 0; const size_t u1 = (size_t)(rbase + 32 * c1) * D + cb; RAa = ldo<u32x4>(QS + u1, soff); RAb = ldo<u32x4>(KD + u1, soff); RAd = ldo<u32x4>(V + u1, soff); RAe = ldo<u32x4>(Gt + u1, soff);
            if (w == 0) RAf = ldo<f32x4>(DCH + (size_t)((rbase >> 5) + c1) * D + cb, (unsigned)(tid & 31) * 16u); }
        u32x4 gprev = {0u, 0u, 0u, 0u};
        for (int ck2 = 0; ck2 < nck; ck2 += 2) {
            GLA_STEP(ck2, RA, RB);
            if (ck2 + 1 < nck) GLA_STEP(ck2 + 1, RB, RA);
        }
        GLA_NORM(nck - 1, gprev);
#pragma unroll
        for (int i = 0; i < 8; ++i)
#pragma unroll
            for (int r = 0; r < 4; ++r) sto<float>(Sout + (16 * i + r) * 128, stoff, S[i][r]);
    }
    __syncthreads();
    conv_queue(C, 5, CV_S4B, CV_S5);
}
#define PHASE_FN __device__ __forceinline__ void
PHASE_FN ph_prologue() { const Ctx C = make_ctx(); p0_prologue(C); }
PHASE_FN ph_gemm_ain() {
    const Ctx C = make_ctx(); unsigned char* const ws_ = wsp(C);
    pg8::Gemm g{(const bf16_t*)(ws_ + WS_XB), (const bf16_t*)(ws_ + WS_W_AIN), M, NAIN, D}; const QueueOrder S = make_queue(C, ws_, 0, M, NAIN);
    EpiGelu E{(bf16_t*)(ws_ + WS_Z), (float*)(ws_ + WS_STAT)};
    pg8::gemm_phase<EpiGelu, QueueOrder, true, true>(C.lds, g, S, E);
    conv_queue(C, 1, CV_S1, CV_S2);
}
#ifdef PROBE_NULL
PHASE_FN ph_probe() {
    const Ctx C = make_ctx(); unsigned char* const ws_ = wsp(C); float* const out_ = outp(C);
    pg8::Gemm g{(const bf16_t*)(ws_ + WS_XB), (const bf16_t*)(ws_ + WS_W_UP0), M, NUP, D}; const QueueOrder S = make_queue(C, ws_, 4 + L, M, NUP);
#if PROBE_NULL == 1
    EpiNull E{(float*)(ws_ + WS_SLAB)};
    pg8::gemm_phase<EpiNull, pg8::StaticOrder, true, true>(C.lds, g, S, E);
#else
    EpiUpConv E{(bf16_t*)(ws_ + WS_HG), (bf16_t*)(ws_ + WS_SIDE), out_ + OUT_CP, out_ + OUT_CS, inp(C, 15), inp(C, 16)};
    pg8::gemm_phase<EpiUpConv, pg8::StaticOrder, true, true>(C.lds, g, S, E);
#endif
}
#endif
PHASE_FN ph_rowstat() { const Ctx C = make_ctx(); p_rowstat(C); }
PHASE_FN ph_spatial() { const Ctx C = make_ctx(); p_spatial(C); }
PHASE_FN ph_gemm_bin() {
    const Ctx C = make_ctx(); unsigned char* const ws_ = wsp(C);
    pg8::Gemm g{(const bf16_t*)(ws_ + WS_XB), (const bf16_t*)(ws_ + WS_W_BIN), M, NBIN, D}; const QueueOrder S = make_queue(C, ws_, 1, M, NBIN);
    EpiBin E{ws_};
    pg8::gemm_phase<EpiBin, QueueOrder, true, true>(C.lds, g, S, E);
}
PHASE_FN ph_gla() { const Ctx C = make_ctx(); p_gla(C); }
template <int L> PHASE_FN ph_gemm_out() {
    const Ctx C = make_ctx(); unsigned char* const ws_ = wsp(C);
    pg8::Gemm g{(const bf16_t*)(ws_ + (L == 0 ? WS_GATED : WS_O)), (const bf16_t*)(ws_ + (L == 0 ? WS_W_AOUT : WS_W_BOUT)), M, D, D}; const QueueOrder S = make_queue(C, ws_, 2 + L, M, D);
    EpiRes<L == 0 ? 0 : 1> E{L == 0 ? inp(C, 0) : nullptr, L == 0 ? inp(C, 1) : nullptr, (const f32x2*)(ws_ + WS_RS2), L == 0 ? nullptr : inp(C, 20), L == 0 ? nullptr : inp(C, 21), (bf16_t*)(ws_ + WS_H32), (float*)(ws_ + WS_STAT)};
    pg8::gemm_phase<EpiRes<L == 0 ? 0 : 1>, QueueOrder, true, true>(C.lds, g, S, E);
    conv_queue(C, L == 0 ? 2 : 6, L == 0 ? CV_S2 : CV_S5, L == 0 ? CV_S3 : CV_END);
}
template <int L> PHASE_FN ph_ln1() { const Ctx C = make_ctx(); unsigned char* const ws_ = wsp(C); p_ln_apply(C, inp(C, 18) + (size_t)L * D, inp(C, 19) + (size_t)L * D, (bf16_t*)(ws_ + WS_XB), nullptr); }
template <int L> PHASE_FN ph_gemm_up() {
    const Ctx C = make_ctx(); unsigned char* const ws_ = wsp(C); float* const out_ = outp(C);
    pg8::Gemm g{(const bf16_t*)(ws_ + WS_XB), (const bf16_t*)(ws_ + (L == 0 ? WS_W_UP0 : WS_W_UP1)), M, NUP, D}; const QueueOrder S = make_queue(C, ws_, 4 + L, M, NUP);
    EpiUpConv E{(bf16_t*)(ws_ + WS_HG), (bf16_t*)(ws_ + WS_SIDE), out_ + OUT_CP + (size_t)L * 4 * 2 * DFF, out_ + OUT_CS + (size_t)L * 32 * 2 * DFF, inp(C, 15) + (size_t)L * 3 * DFF, inp(C, 16) + (size_t)L * DFF};
    pg8::gemm_phase<EpiUpConv, QueueOrder, true, true>(C.lds, g, S, E);
    if (L == 0) conv_queue(C, 3, CV_S3, CV_S4);
}
template <int L> PHASE_FN ph_conv() { const Ctx C = make_ctx(); p_convfix(C, L); }
template <int L> PHASE_FN ph_gemm_dn() {
    const Ctx C = make_ctx(); unsigned char* const ws_ = wsp(C);
    pg8::Gemm g{(const bf16_t*)(ws_ + WS_HG), (const bf16_t*)(ws_ + (L == 0 ? WS_W_DN0 : WS_W_DN1)), M, D, DFF}; QueueOrder S = make_queue(C, ws_, 6 + L, M, D);
    EpiRes<1> E{nullptr, nullptr, (const f32x2*)(ws_ + WS_RS2), inp(C, 18) + (size_t)L * D, inp(C, 19) + (size_t)L * D, (bf16_t*)(ws_ + WS_H32), (float*)(ws_ + WS_STAT)};
    if (L == 1 && C.G == 256) {
        S.b.cap = 4 * 256;
        pg8::gemm_phase<EpiRes<1>, QueueOrder, true, true>(C.lds, g, S, E);
        const int kq = C.bid & 3, kt0 = kq == 0 ? 0 : (kq == 1 ? 44 : (kq == 2 ? 88 : 130)), nkt = kq < 2 ? 44 : 42;
        pg8::Gemm g2{g.A + kt0 * 64, g.Bt + kt0 * 64, M, D, nkt * 64, DFF};
        SplitOrder S2; S2.b.init(M, D, C.G, 0); S2.L = 4 * 256 + (C.bid >> 2);
        EpiPartial E2{(float*)(ws_ + WS_SLAB) + (size_t)C.bid * 65536};
        pg8::gemm_phase<EpiPartial, SplitOrder, true, true>(C.lds, g2, S2, E2);
    } else {
        pg8::gemm_phase<EpiRes<1>, QueueOrder, true, true>(C.lds, g, S, E);
        if (L == 0) conv_queue(C, 4, CV_S4, CV_S4B);
    }
}
PHASE_FN ph_dnfix() {
    const Ctx C = make_ctx(); unsigned char* const ws_ = wsp(C);
    if (C.G != 256) return;
    EpiRes<1> E{nullptr, nullptr, (const f32x2*)(ws_ + WS_RS2), inp(C, 18) + (size_t)D, inp(C, 19) + (size_t)D, (bf16_t*)(ws_ + WS_H32), (float*)(ws_ + WS_STAT)};
    pg8::StaticOrder S; S.init(M, D, C.G, 0);
    const int wr = C.wave >> 2, wc = C.wave & 3, fr = C.lane & 15, fq = C.lane >> 4;
    const unsigned t = (unsigned)(((wr * 4 + wc) * 4 + fq) * 16 + fr);
    for (int idx = C.bid >> 1; idx < 64 && C.bid < 128; idx += 64) {
        pg8::Unit u; if (!S.unit_of(4 * 256 + idx, u)) break;
        const float* slab = (const float*)(ws_ + WS_SLAB) + (size_t)idx * 4 * 65536;
        pg8::f32x4 acc[2][2][4][2];
#define DNFIX_HALF(AI) do { \
            _Pragma("unroll") for (int bj = 0; bj < 2; ++bj) _Pragma("unroll") for (int m = 0; m < 4; ++m) { \
                  \
                const unsigned o0 = ((unsigned)(((((AI) * 2 + bj) * 4 + m) * 2 + 0) * 512) + t) * 16u, o1 = o0 + 512u * 16u; \
                const pg8::f32x4 a0 = ldo<pg8::f32x4>(slab, o0), a1 = ldo<pg8::f32x4>(slab + 65536, o0), a2 = ldo<pg8::f32x4>(slab + 2 * 65536, o0), a3 = ldo<pg8::f32x4>(slab + 3 * 65536, o0); \
                const pg8::f32x4 b0 = ldo<pg8::f32x4>(slab, o1), b1 = ldo<pg8::f32x4>(slab + 65536, o1), b2 = ldo<pg8::f32x4>(slab + 2 * 65536, o1), b3 = ldo<pg8::f32x4>(slab + 3 * 65536, o1); \
                acc[AI][bj][m][0] = (a0 + a1) + (a2 + a3); acc[AI][bj][m][1] = (b0 + b1) + (b2 + b3); } \
            E.run<AI, AI + 1>(acc, u, wr, wc, fr, fq); } while (0)
        if ((C.bid & 1) == 0) DNFIX_HALF(0); else DNFIX_HALF(1);
#undef DNFIX_HALF
    }
}
template <int L> PHASE_FN ph_ln2() {
    const Ctx C = make_ctx(); unsigned char* const ws_ = wsp(C);
    p_ln_apply(C, inp(C, 20) + (size_t)L * D, inp(C, 21) + (size_t)L * D, L == 0 ? (bf16_t*)(ws_ + WS_XB) : nullptr, L == 0 ? nullptr : outp(C) + OUT_Y);
}
PHASE_FN ph_barrier() {
    const Ctx C = make_ctx();
    XcdBarrier b; b.bar = (unsigned*)(wsp(C) + WS_CTL) + CW_BAR; b.x = xb_xcc_id(); b.st = (volatile LAS unsigned*)(C.lds + MISC_OFF) + 8;
    xcd_barrier(b);
}

struct Args { const float* in[22]; float* out; unsigned char* ws; int ph_lo, ph_hi; };
static_assert(sizeof(Args) == 22 * 8 + 8 + 8 + 8, "Args has no padding");

__global__ void __launch_bounds__(512, 2) fwd_kernel(Args args) {
    LAS unsigned char* lds = (LAS unsigned char*)lds_raw;
    const int tid = threadIdx.x;
    volatile LAS unsigned* MISC = (volatile LAS unsigned*)(lds + MISC_OFF);
    if (tid < 64) MISC[tid] = 0u;
    if (tid == 64) {
        volatile LAS unsigned long long* pt = (volatile LAS unsigned long long*)(lds + PTR_OFF);
#pragma unroll
        for (int i = 0; i < 22; ++i) pt[i] = (unsigned long long)args.in[i];
        pt[22] = (unsigned long long)args.out; pt[23] = (unsigned long long)args.ws;
    }
    __syncthreads();
    if (N_LAUNCHES == 1) (void)xcd_barrier_post((unsigned*)(args.ws + WS_CTL) + CW_BAR, MISC + 8);
#ifndef REPS
#define REPS {1,1,1,1,1,1,1,1,1,1,1,1,1,1,1,1,1,1,1,1}
#endif
    constexpr int REPS_[NPHASE] = REPS;
    const int lo = args.ph_lo, hi = args.ph_hi;
#define IN(k) (lo <= (k) && (k) < hi)
#define SEAM(k) do { if (IN(k) && IN((k) + 1)) ph_barrier(); } while (0)
    if (IN(0)) { for (int r_ = 0; r_ < REPS_[0]; ++r_) ph_prologue(); }
    SEAM(0);
    if (IN(1)) { for (int r_ = 0; r_ < REPS_[1]; ++r_) ph_gemm_ain(); }

    SEAM(1);
    if (IN(2)) { for (int r_ = 0; r_ < REPS_[2]; ++r_) ph_rowstat(); }
    SEAM(2);
    if (IN(3)) { for (int r_ = 0; r_ < REPS_[3]; ++r_) ph_spatial(); }
    SEAM(3);
    if (IN(4)) { for (int r_ = 0; r_ < REPS_[4]; ++r_) ph_gemm_out<0>(); }
    SEAM(4);
    if (IN(5)) { for (int r_ = 0; r_ < REPS_[5]; ++r_) ph_ln1<0>(); }
    SEAM(5);
    if (IN(6)) { for (int r_ = 0; r_ < REPS_[6]; ++r_) ph_gemm_up<0>(); }
#ifdef PROBE_NULL
    if (IN(6)) { ph_barrier(); ph_probe(); }
#endif
    SEAM(6);
    if (IN(7)) { for (int r_ = 0; r_ < REPS_[7]; ++r_) ph_conv<0>(); }
    SEAM(7);
    if (IN(8)) { for (int r_ = 0; r_ < REPS_[8]; ++r_) ph_gemm_dn<0>(); }
    SEAM(8);
    if (IN(9)) { for (int r_ = 0; r_ < REPS_[9]; ++r_) ph_ln2<0>(); }
    SEAM(9);
    if (IN(10)) { for (int r_ = 0; r_ < REPS_[10]; ++r_) ph_gemm_bin(); }
    SEAM(10);
    if (IN(12)) { for (int r_ = 0; r_ < REPS_[12]; ++r_) ph_gla(); }
    SEAM(12);
    if (IN(13)) { for (int r_ = 0; r_ < REPS_[13]; ++r_) ph_gemm_out<1>(); }
    SEAM(13);
    if (IN(14)) { for (int r_ = 0; r_ < REPS_[14]; ++r_) ph_ln1<1>(); }
    SEAM(14);
    if (IN(15)) { for (int r_ = 0; r_ < REPS_[15]; ++r_) ph_gemm_up<1>(); }
    SEAM(15);
    if (IN(16)) { for (int r_ = 0; r_ < REPS_[16]; ++r_) ph_conv<1>(); }
    SEAM(16);
    if (IN(17)) { for (int r_ = 0; r_ < REPS_[17]; ++r_) ph_gemm_dn<1>(); }
    SEAM(17);
    if (IN(18)) { for (int r_ = 0; r_ < REPS_[18]; ++r_) ph_dnfix(); }
    SEAM(18);
    if (IN(19)) { for (int r_ = 0; r_ < REPS_[19]; ++r_) ph_ln2<1>(); }
#undef IN
#undef SEAM
}

#ifdef DBG_STOP
__global__ void dbg_fold(const unsigned* src, size_t n_words, float* out, size_t n_out) {
    for (size_t j = (size_t)blockIdx.x * blockDim.x + threadIdx.x; j < n_out; j += (size_t)gridDim.x * blockDim.x) {
        unsigned acc = 0u; for (size_t i = j; i < n_words; i += n_out) acc ^= src[i];
        acc ^= acc >> 16; acc ^= acc >> 8; out[j] = (float)(acc & 0xffu);
    }
}
#endif
extern "C" void kernel_launch(void* const* d_in, const int* in_sizes, int n_in, void* d_out, int out_size, void* d_ws, size_t ws_size, hipStream_t stream) {
    static int grid = 0;
    if (grid == 0) {
        if (n_in != 22 || (size_t)out_size != OUT_END || ws_size < WS_END) { fprintf(stderr, "kernel_launch: unexpected shapes (n_in %d, out %d, ws %zu)\n", n_in, out_size, ws_size); grid = -1; return; }
        int dev = 0, cus = 0;
        if (hipGetDevice(&dev) != hipSuccess || hipDeviceGetAttribute(&cus, hipDeviceAttributeMultiprocessorCount, dev) != hipSuccess) { grid = -1; return; }
        if (hipFuncSetAttribute((const void*)fwd_kernel, hipFuncAttributeMaxDynamicSharedMemorySize, LDS_BYTES) != hipSuccess) { fprintf(stderr, "kernel_launch: hipFuncSetAttribute failed\n"); grid = -1; return; }
        int per_cu = 0;
        if (hipOccupancyMaxActiveBlocksPerMultiprocessor(&per_cu, (const void*)fwd_kernel, 512, LDS_BYTES) != hipSuccess || per_cu < 1) fprintf(stderr, "kernel_launch: occupancy query says %d\n", per_cu);
        (void)hipGetLastError();
        grid = cus;
    }
    if (grid < 0) return;
    (void)hipMemsetAsync((char*)d_ws + WS_CTL, 0, CTL_BYTES, stream);
    Args a{};
    for (int i = 0; i < 22; ++i) a.in[i] = (const float*)d_in[i];
    a.out = (float*)d_out; a.ws = (unsigned char*)d_ws;
    if (N_LAUNCHES == 1) { a.ph_lo = 0; a.ph_hi = NPHASE; hipLaunchKernelGGL(fwd_kernel, dim3(grid), dim3(512), LDS_BYTES, stream, a); }
    else for (int p = 0; p < NPHASE; ++p) {
#ifdef DBG_STOP
        if (p > DBG_STOP) break;
#endif
        a.ph_lo = p; a.ph_hi = p + 1; hipLaunchKernelGGL(fwd_kernel, dim3(grid), dim3(512), LDS_BYTES, stream, a); }
#ifdef DBG_STOP
    hipLaunchKernelGGL(dbg_fold, dim3(2048), dim3(256), 0, stream, (const unsigned*)((const char*)d_ws + (size_t)(DBG_OFF)), (size_t)(DBG_BYTES) / 4, (float*)d_out, (size_t)out_size);
#endif
}
```
